# Optimizing an MI355X kernel written in HIP

```python
import jax, jax.numpy as jnp
from jax import lax
import numpy as np

D_MODEL = 2048
BATCH = 8
SEQ = 2048
DEPTH = 1

GDN_HEADS = 8
GDN_HEAD_DIM = 128
GDN_WIDTH = GDN_HEADS * GDN_HEAD_DIM
CONV_WIDTH = 4
GDN_CHUNK = 64
MOBA_HEADS = 8
MOBA_HEAD_DIM = 128
MOBA_WIDTH = MOBA_HEADS * MOBA_HEAD_DIM
MOBA_BLOCK = 256
MOBA_TOPK = 3
MOBA_QCHUNK = 128

NORM_EPS = 1e-6
NEG_INF = -1e30
SPLITS = (3 * GDN_WIDTH, GDN_WIDTH, GDN_HEADS, GDN_HEADS, 3 * MOBA_WIDTH, MOBA_WIDTH, D_MODEL, D_MODEL)
IN_WIDTH = 3 * GDN_WIDTH + GDN_WIDTH + 2 * GDN_HEADS + 3 * MOBA_WIDTH + MOBA_WIDTH + 2 * D_MODEL

kernel_name = "hybrid_gdn_moba_gated_merge"


def rms_norm(x, w):
    xf = x.astype(jnp.float32)
    y = xf * lax.rsqrt(jnp.mean(xf * xf, axis=-1, keepdims=True) + NORM_EPS)
    return (y * w.astype(jnp.float32)).astype(x.dtype)


def l2_normalize(x):
    return x * lax.rsqrt(jnp.sum(x * x, axis=-1, keepdims=True) + NORM_EPS)


def causal_depthwise_conv(x, w):
    K = w.shape[0]
    S = x.shape[1]
    xp = jnp.pad(x, ((0, 0), (K - 1, 0), (0, 0)))
    out = w[0] * xp[:, 0:S]
    for j in range(1, K):
        out = out + w[j] * xp[:, j:j + S]
    return out


def gated_delta_rule(q, k, v, beta, g):
    B, H, S, dk = q.shape
    dv = v.shape[-1]
    C = GDN_CHUNK
    N = S // C
    q = q * (dk ** -0.5)
    q = q.reshape(B, H, N, C, dk)
    k = k.reshape(B, H, N, C, dk)
    v = v.reshape(B, H, N, C, dv)
    beta = beta.reshape(B, H, N, C)
    g = jnp.cumsum(g.reshape(B, H, N, C), axis=-1)
    kb = k * beta[..., None]
    vb = v * beta[..., None]
    incl = jnp.tril(jnp.ones((C, C), dtype=bool))
    strict = jnp.tril(jnp.ones((C, C), dtype=bool), -1)
    decay = jnp.exp(jnp.where(incl, g[..., :, None] - g[..., None, :], NEG_INF))
    L = jnp.where(strict, jnp.einsum('bhnid,bhnjd->bhnij', kb, k) * decay, 0.0)
    eye = jnp.eye(C, dtype=jnp.float32)
    T = lax.linalg.triangular_solve(L + eye, jnp.broadcast_to(eye, L.shape), left_side=True, lower=True)
    u = jnp.einsum('bhnij,bhnje->bhnie', T, vb)
    w = jnp.einsum('bhnij,bhnjd->bhnid', T, kb * jnp.exp(g)[..., None])
    intra = jnp.where(incl, jnp.einsum('bhnid,bhnjd->bhnij', q, k) * decay, 0.0)
    qg = q * jnp.exp(g)[..., None]
    kdec = k * jnp.exp(g[..., -1:] - g)[..., None]
    g_last = jnp.exp(g[..., -1])
    xs = (jnp.moveaxis(qg, 2, 0), jnp.moveaxis(kdec, 2, 0), jnp.moveaxis(u, 2, 0),
          jnp.moveaxis(w, 2, 0), jnp.moveaxis(intra, 2, 0), jnp.moveaxis(g_last, 2, 0))

    def step(state, inp):
        qg_i, kd_i, u_i, w_i, a_i, gl_i = inp
        v_new = u_i - jnp.einsum('bhcd,bhde->bhce', w_i, state)
        o = jnp.einsum('bhcd,bhde->bhce', qg_i, state) + jnp.einsum('bhij,bhje->bhie', a_i, v_new)
        state = state * gl_i[..., None, None] + jnp.einsum('bhcd,bhce->bhde', kd_i, v_new)
        return state, o

    state0 = jnp.zeros((B, H, dk, dv), jnp.float32)
    _, o = lax.scan(step, state0, xs)
    return jnp.moveaxis(o, 0, 2).reshape(B, H, S, dv)


def moba_attention(q, k, v):
    B, S, H, d = q.shape
    NB = -(-S // MOBA_BLOCK)
    S_pad = NB * MOBA_BLOCK
    QC = MOBA_QCHUNK
    NQ = S // QC
    k_sel = min(MOBA_TOPK, NB)
    pad = ((0, 0), (0, S_pad - S), (0, 0), (0, 0))
    kp = jnp.pad(k, pad).reshape(B, NB, MOBA_BLOCK, H, d).transpose(0, 3, 1, 2, 4)
    vp = jnp.pad(v, pad).reshape(B, NB, MOBA_BLOCK, H, d).transpose(0, 3, 1, 2, 4)
    kmean = jnp.mean(kp.astype(jnp.float32), axis=3)
    qh = q.transpose(0, 2, 1, 3)
    gate = jnp.einsum('bhsd,bhnd->bhsn', qh.astype(jnp.float32), kmean)
    q_blk = jnp.arange(S) // MOBA_BLOCK
    fully_past = jnp.arange(NB)[None, :] < q_blk[:, None]
    gate = jnp.where(fully_past, gate, NEG_INF)
    _, idx = lax.top_k(gate, k_sel)

    q_steps = qh.reshape(B, H, NQ, QC, d).transpose(0, 2, 1, 3, 4).reshape(B * NQ, H, QC, d)
    idx_steps = idx.reshape(B, H, NQ, QC, k_sel).transpose(0, 2, 1, 3, 4).reshape(B * NQ, H, QC, k_sel)
    b_ids = jnp.repeat(jnp.arange(B, dtype=jnp.int32), NQ)
    c_ids = jnp.tile(jnp.arange(NQ, dtype=jnp.int32), B)
    scale = MOBA_HEAD_DIM ** -0.5
    hh = jnp.arange(H)[:, None, None]

    def step(args):
        qc, ic, b, c = args
        kb = kp[b]
        vb = vp[b]
        kg = kb[hh, ic]
        vg = vb[hh, ic]
        own = (c * QC) // MOBA_BLOCK
        ko = lax.dynamic_index_in_dim(kb, own, axis=1, keepdims=False)
        vo = lax.dynamic_index_in_dim(vb, own, axis=1, keepdims=False)
        s_past = jnp.einsum('hqd,hqjpd->hqjp', qc, kg, preferred_element_type=jnp.float32)
        s_past = s_past.reshape(H, QC, k_sel * MOBA_BLOCK)
        s_own = jnp.einsum('hqd,hpd->hqp', qc, ko, preferred_element_type=jnp.float32)
        t_abs = c * QC + jnp.arange(QC)
        slot_ok = jnp.arange(k_sel)[None, :] < (t_abs // MOBA_BLOCK)[:, None]
        slot_ok = jnp.broadcast_to(slot_ok[:, :, None], (QC, k_sel, MOBA_BLOCK)).reshape(QC, k_sel * MOBA_BLOCK)
        own_ok = (own * MOBA_BLOCK + jnp.arange(MOBA_BLOCK))[None, :] <= t_abs[:, None]
        mask = jnp.concatenate([slot_ok, own_ok], axis=-1)[None]
        s = jnp.concatenate([s_past, s_own], axis=-1) * scale
        p = jax.nn.softmax(jnp.where(mask, s, NEG_INF), axis=-1).astype(vg.dtype)
        p_past = p[..., :k_sel * MOBA_BLOCK].reshape(H, QC, k_sel, MOBA_BLOCK)
        p_own = p[..., k_sel * MOBA_BLOCK:]
        return (jnp.einsum('hqjp,hqjpd->hqd', p_past, vg)
                + jnp.einsum('hqp,hpd->hqd', p_own, vo))

    o = lax.map(step, (q_steps, idx_steps, b_ids, c_ids))
    return o.reshape(B, NQ, H, QC, d).transpose(0, 1, 3, 2, 4).reshape(B, S, H * d)


def hybrid_mixer(h, w_in, conv_w, a_log, dt_bias, gdn_norm_w, w_branch_a, w_branch_b, w_out):
    B, S, _ = h.shape
    proj = h @ w_in
    offsets = []
    acc = 0
    for n in SPLITS[:-1]:
        acc += n
        offsets.append(acc)
    gdn_qkv, gdn_z, gdn_b, gdn_a, moba_qkv, moba_z, gate_a, gate_b = jnp.split(proj, offsets, axis=-1)

    qkv = jax.nn.silu(causal_depthwise_conv(gdn_qkv, conv_w)).astype(jnp.float32)
    qa, ka, va = jnp.split(qkv, 3, axis=-1)
    to_heads = lambda t: t.reshape(B, S, GDN_HEADS, GDN_HEAD_DIM).transpose(0, 2, 1, 3)
    qa, ka, va = l2_normalize(to_heads(qa)), l2_normalize(to_heads(ka)), to_heads(va)
    beta = jax.nn.sigmoid(gdn_b.astype(jnp.float32)).transpose(0, 2, 1)
    g = (-jnp.exp(a_log.astype(jnp.float32))
         * jax.nn.softplus(gdn_a.astype(jnp.float32) + dt_bias.astype(jnp.float32))).transpose(0, 2, 1)
    oa = gated_delta_rule(qa, ka, va, beta, g).transpose(0, 2, 1, 3)
    oa = oa * lax.rsqrt(jnp.mean(oa * oa, axis=-1, keepdims=True) + NORM_EPS)
    za = gdn_z.astype(jnp.float32).reshape(B, S, GDN_HEADS, GDN_HEAD_DIM)
    oa = (oa * gdn_norm_w.astype(jnp.float32) * jax.nn.silu(za)).reshape(B, S, GDN_WIDTH).astype(h.dtype)
    u_a = oa @ w_branch_a

    qb, kb, vb = jnp.split(moba_qkv, 3, axis=-1)
    to_mh = lambda t: t.reshape(B, S, MOBA_HEADS, MOBA_HEAD_DIM)
    ob = moba_attention(to_mh(qb), to_mh(kb), to_mh(vb)).astype(h.dtype)
    ob = ob * jax.nn.silu(moba_z)
    u_b = ob @ w_branch_b

    merged = jax.nn.sigmoid(gate_a) * u_a + jax.nn.sigmoid(gate_b) * u_b
    return merged @ w_out


def setup_inputs(seed: int = 0) -> dict:
    key = jax.random.key(seed)
    ks = jax.random.split(key, 12)
    f32 = jnp.float32
    x = jax.random.normal(ks[0], (BATCH, SEQ, D_MODEL), f32)
    pre_norm_w = 1.0 + 0.05 * jax.random.normal(ks[1], (DEPTH, D_MODEL), f32)
    w_in = jax.random.normal(ks[2], (DEPTH, D_MODEL, IN_WIDTH), f32) * (D_MODEL ** -0.5)
    conv_w = jax.random.normal(ks[3], (DEPTH, CONV_WIDTH, 3 * GDN_WIDTH), f32) * (CONV_WIDTH ** -0.5)
    a_log = jnp.log(jax.random.uniform(ks[4], (DEPTH, GDN_HEADS), f32, minval=1.0, maxval=16.0))
    dt = jnp.exp(jax.random.uniform(ks[5], (DEPTH, GDN_HEADS), f32, minval=np.log(1e-3), maxval=np.log(1e-1)))
    dt_bias = dt + jnp.log(-jnp.expm1(-dt))
    gdn_norm_w = 1.0 + 0.05 * jax.random.normal(ks[6], (DEPTH, GDN_HEAD_DIM), f32)
    w_branch_a = jax.random.normal(ks[7], (DEPTH, GDN_WIDTH, D_MODEL), f32) * (GDN_WIDTH ** -0.5)
    w_branch_b = jax.random.normal(ks[8], (DEPTH, MOBA_WIDTH, D_MODEL), f32) * (MOBA_WIDTH ** -0.5)
    w_out = jax.random.normal(ks[9], (DEPTH, D_MODEL, D_MODEL), f32) * (D_MODEL ** -0.5)
    post_norm_w = 1.0 + 0.05 * jax.random.normal(ks[10], (DEPTH, D_MODEL), f32)
    return {"x": x, "pre_norm_w": pre_norm_w, "w_in": w_in, "conv_w": conv_w, "a_log": a_log,
            "dt_bias": dt_bias, "gdn_norm_w": gdn_norm_w, "w_branch_a": w_branch_a,
            "w_branch_b": w_branch_b, "w_out": w_out, "post_norm_w": post_norm_w}


def reference(x, pre_norm_w, w_in, conv_w, a_log, dt_bias, gdn_norm_w, w_branch_a, w_branch_b, w_out, post_norm_w):
    for l in range(DEPTH):
        h = rms_norm(x, pre_norm_w[l])
        y = hybrid_mixer(h, w_in[l], conv_w[l], a_log[l], dt_bias[l], gdn_norm_w[l],
                         w_branch_a[l], w_branch_b[l], w_out[l])
        x = x + rms_norm(y, post_norm_w[l])
    return x
```

```cpp
#include <hip/hip_runtime.h>
#include <hip/hip_cooperative_groups.h>
#include <cstdio>
#include <cstdint>
namespace cg = cooperative_groups;

#ifndef ONE_LAUNCH
#define ONE_LAUNCH 1
#endif

#ifndef CP_REPEAT
#define CP_REPEAT 1
#endif
#ifndef SCAN_REPEAT
#define SCAN_REPEAT 1
#endif
#ifndef MOBA_REPEAT
#define MOBA_REPEAT 1
#endif
#ifndef WGM_G1
#define WGM_G1 4
#endif
#ifndef WGM_G2
#define WGM_G2 4
#endif
#ifndef WGM_G3
#define WGM_G3 4
#endif
#ifndef REPEAT_MASK
#define REPEAT_MASK 0
#endif
#define LAS __attribute__((address_space(3)))
typedef unsigned short bf16_t;
typedef short bf16x8 __attribute__((ext_vector_type(8)));
typedef float f32x4 __attribute__((ext_vector_type(4)));
typedef unsigned u32x4 __attribute__((ext_vector_type(4)));
typedef unsigned u32x2 __attribute__((ext_vector_type(2)));

constexpr int NTHR = 512;
constexpr int LDS_BYTES = 155648;
constexpr int SEQ = 2048, DM = 2048, MTOK = 16384, NPROJ = 8192, N1 = 12288, INW = 12304;
constexpr size_t MiB = 1u << 20;

struct Params {
    const float *x, *pre_w, *w_in, *conv_w, *a_log, *dt_bias, *gdn_nw, *w_a, *w_b, *w_out, *post_w;
    float* out;
    bf16_t *H, *PROJ, *WinT, *WabT, *WoT, *GQ, *GK, *GV, *ORAW, *AB, *MERGED, *Y;
    float *BETA, *G, *KMEAN, *RSS, *GL;
    bf16_t* WN;
    unsigned* BAR;
    bf16_t *GR, *GB;
};

__device__ __forceinline__ float bf2f(bf16_t v) { return __uint_as_float(((unsigned)v) << 16); }
__device__ __forceinline__ float bflo(unsigned w) { return __uint_as_float(w << 16); }
__device__ __forceinline__ float bfhi(unsigned w) { return __uint_as_float(w & 0xffff0000u); }
typedef __bf16 hwbf16x2 __attribute__((ext_vector_type(2)));
typedef float f32x2v __attribute__((ext_vector_type(2)));
__device__ __forceinline__ unsigned cvt_pk_bf16(float lo, float hi) { f32x2v v = {lo, hi}; hwbf16x2 b = __builtin_convertvector(v, hwbf16x2); return __builtin_bit_cast(unsigned, b); }
__device__ __forceinline__ unsigned pk2(float lo, float hi) { return cvt_pk_bf16(lo, hi); }
__device__ __forceinline__ bf16_t f2bf(float f) { return (bf16_t)(cvt_pk_bf16(f, 0.f) & 0xffffu); }
__device__ __forceinline__ float sigmoidf_(float v) { return __builtin_amdgcn_rcpf(1.0f + __expf(-v)); }
__device__ __forceinline__ float siluf_(float v) { return v * sigmoidf_(v); }
__device__ __forceinline__ void lds_sync() { asm volatile("s_waitcnt lgkmcnt(0)" ::: "memory"); __builtin_amdgcn_s_barrier(); asm volatile("" ::: "memory"); }
#define XB_TMO      128
#define XB_XCNT(j)  (256  + 64 * (j))
#define XB_XSUB(j)  (1280 + 64 * (j))
#define XB_XGEN(j)  (2304 + 64 * (j))
#define XB_TOP      3328
#define XB_TOPGEN   3392
#define XCD_BAR_WORDS 3456
#define XB_SPIN_CAP (1u << 20)
__device__ __forceinline__ unsigned xb_ld(unsigned* p)              { return __hip_atomic_load(p, __ATOMIC_RELAXED, __HIP_MEMORY_SCOPE_AGENT); }
__device__ __forceinline__ unsigned xb_add(unsigned* p, unsigned v) { return __hip_atomic_fetch_add(p, v, __ATOMIC_RELAXED, __HIP_MEMORY_SCOPE_AGENT); }
__device__ __forceinline__ unsigned xb_xcc_id() { return (unsigned)__builtin_amdgcn_s_getreg((3 << 11) | 20) & 0xFu; }
#define XB_SPIN(cond, bar) do { unsigned _sp = 0; while (cond) { __builtin_amdgcn_s_sleep(1); \
    if ((++_sp & 255u) == 0u) { if (xb_ld(&(bar)[XB_TMO])) break; if (_sp > XB_SPIN_CAP) { atomicAdd(&(bar)[XB_TMO], 1u); break; } } } } while (0)
struct XcdBarrier { unsigned* bar; unsigned x; volatile LAS unsigned* st; };
__device__ __forceinline__ XcdBarrier xcd_barrier_post(unsigned* bar, volatile LAS unsigned* st) {
    XcdBarrier b; b.bar = bar; b.x = xb_xcc_id(); b.st = st;
    if (threadIdx.x == 0) (void)xb_add(&bar[XB_XCNT(b.x)], 1u);
    return b;
}
__device__ __forceinline__ void xcd_barrier_complete(unsigned* bar, unsigned x, unsigned& nloc, unsigned& nx) {
    const unsigned G = gridDim.x * gridDim.y * gridDim.z;
    unsigned sum, cnt, mine, sp = 0u;
    for (;;) {
        sum = 0u; cnt = 0u; mine = 0u;
#pragma unroll
        for (unsigned j = 0; j < 16; ++j) { const unsigned c = xb_ld(&bar[XB_XCNT(j)]); sum += c; cnt += (c > 0u) ? 1u : 0u; mine = (j == x) ? c : mine; }
        if (sum == G) break;
        __builtin_amdgcn_s_sleep(1);
        if ((++sp & 255u) == 0u) { if (xb_ld(&bar[XB_TMO])) break; if (sp > XB_SPIN_CAP) { atomicAdd(&bar[XB_TMO], 1u); break; } }
    }
    nloc = mine > 0u ? mine : 1u; nx = cnt > 0u ? cnt : 1u;
}
__device__ __forceinline__ void xcd_barrier(const XcdBarrier& b) {
    asm volatile("s_waitcnt vmcnt(0)" ::: "memory");
    __syncthreads();
    if (threadIdx.x == 0) {
        unsigned* bar = b.bar;
        __builtin_amdgcn_s_waitcnt(0);
        unsigned nloc = b.st[0], nx = b.st[1];
        if (nloc == 0u) { xcd_barrier_complete(bar, b.x, nloc, nx); b.st[0] = nloc; b.st[1] = nx; }
        const unsigned old = xb_add(&bar[XB_XSUB(b.x)], 1u);
        const unsigned gen = old / nloc;
        if (old + 1u == (gen + 1u) * nloc) {
            __builtin_amdgcn_fence(__ATOMIC_RELEASE, "agent");
            asm volatile("s_waitcnt vmcnt(0)" ::: "memory");
            const unsigned og = xb_add(&bar[XB_TOP], 1u);
            const unsigned tg = og / nx;
            if (og + 1u == (tg + 1u) * nx) xb_add(&bar[XB_TOPGEN], 1u);
            else XB_SPIN(xb_ld(&bar[XB_TOPGEN]) == tg, bar);
            __builtin_amdgcn_fence(__ATOMIC_ACQUIRE, "agent");
            xb_add(&bar[XB_XGEN(b.x)], 1u);
            asm volatile("s_waitcnt vmcnt(0)" ::: "memory");
        } else {
            XB_SPIN(xb_ld(&bar[XB_XGEN(b.x)]) == gen, bar);
            __builtin_amdgcn_fence(__ATOMIC_ACQUIRE, "agent");
            asm volatile("s_waitcnt vmcnt(0)" ::: "memory");
        }
    }
    __syncthreads();
}
__device__ __forceinline__ void grid_barrier(unsigned* ctr, unsigned target) {
    asm volatile("s_waitcnt vmcnt(0)" ::: "memory");
    __syncthreads();
    if (threadIdx.x < 64) {
        if (threadIdx.x == 0) {
            __builtin_amdgcn_fence(__ATOMIC_RELEASE, "agent");
            asm volatile("s_waitcnt vmcnt(0)" ::: "memory");
            __hip_atomic_fetch_add(ctr, 1u, __ATOMIC_RELAXED, __HIP_MEMORY_SCOPE_AGENT);
            unsigned spins = 0;
            while (__hip_atomic_load(ctr, __ATOMIC_RELAXED, __HIP_MEMORY_SCOPE_AGENT) < target) { __builtin_amdgcn_s_sleep(2); if (++spins > (1u << 24)) break; }
        }
        __builtin_amdgcn_fence(__ATOMIC_ACQUIRE, "agent");
        asm volatile("s_waitcnt vmcnt(0)" ::: "memory");
    }
    __syncthreads();
}
__device__ __forceinline__ void flag_arrive(unsigned* ctr) {
    asm volatile("s_waitcnt vmcnt(0)" ::: "memory");
    __syncthreads();
    if (threadIdx.x == 0) __hip_atomic_fetch_add(ctr, 1u, __ATOMIC_RELAXED, __HIP_MEMORY_SCOPE_AGENT);
}
__device__ __forceinline__ void flag_wait3(unsigned* c0, unsigned* c1, unsigned* c2, unsigned target) {
    if (threadIdx.x < 64) {
        if (threadIdx.x == 0) { unsigned spins = 0;
            while (__hip_atomic_load(c0, __ATOMIC_RELAXED, __HIP_MEMORY_SCOPE_AGENT) < target || __hip_atomic_load(c1, __ATOMIC_RELAXED, __HIP_MEMORY_SCOPE_AGENT) < target ||
                   __hip_atomic_load(c2, __ATOMIC_RELAXED, __HIP_MEMORY_SCOPE_AGENT) < target) { __builtin_amdgcn_s_sleep(2); if (++spins > (1u << 24)) break; } }
        __builtin_amdgcn_fence(__ATOMIC_ACQUIRE, "agent");
        asm volatile("s_waitcnt vmcnt(0)" ::: "memory");
    }
    __syncthreads();
}
__device__ __forceinline__ float wave_sum(float v) {
#pragma unroll
    for (int o = 32; o >= 1; o >>= 1) v += __shfl_xor(v, o);
    return v;
}

namespace gm {
constexpr int BM = 256, BK = 64, HALF = 128, HTB = HALF * BK * 2, NXCD = 8, LD = 2048;
__device__ __forceinline__ int lds_byte(int r, int c) { const int st = (r >> 4) * 2 + (c >> 5), rr = r & 15, cc = c & 31, ob = rr * 64 + cc * 2; return st * 1024 + (ob ^ (((ob >> 9) & 1) << 5)); }
__device__ __forceinline__ void stage_rc(int b, int& R, int& C) { const int st = b / 1024, sb = b % 1024, swz = sb ^ (((sb >> 9) & 1) << 5); R = (st >> 1) * 16 + swz / 64; C = (st & 1) * 32 + (swz % 64) / 2; }
__device__ __forceinline__ int perm32(int rho) { const int n = rho >> 4, i = rho & 15; return 8 * (i >> 2) + 4 * n + (i & 3); }

struct Unit { int pm, pn, half; };
struct Order {
    int nM, nN, nwg, G, c, two, WGM;
    __device__ void init(int M, int N, int G_, int c_, int two_, int wgm_) { nM = M / BM; nN = N / BM; nwg = nM * nN; G = G_; c = c_; two = two_; WGM = wgm_; }
    __device__ bool next(int i, Unit& u) const {
        const int ti = two ? (i >> 1) : i; u.half = two ? (i & 1) : 0;
        const long L = (long)ti * G + c; if (L >= nwg) return false;
        int wgid = (int)L; { const int q = nwg / NXCD, r = nwg % NXCD, xcd = wgid % NXCD, off = wgid / NXCD; wgid = (xcd < r ? xcd * (q + 1) : r * (q + 1) + (xcd - r) * q) + off; }
        const int nig = WGM * nN, gid = wgid / nig, fm = gid * WGM, gsz = (nM - fm) < WGM ? (nM - fm) : WGM;
        u.pm = fm + ((wgid % nig) % gsz); u.pn = (wgid % nig) / gsz; return true;
    }
};

template <class Epi, bool ALIGN_EPI = true, bool SP2 = true>
__device__ __forceinline__ void gemm_phase(LAS unsigned char* lds, const bf16_t* Abase, const bf16_t* Bbase, const int nt, const Order& S, const Epi& E) {
    int tid_ = threadIdx.x; asm volatile("" : "+v"(tid_));
    const int tid = tid_, wid = __builtin_amdgcn_readfirstlane(tid >> 6), lane = tid & 63, wr = wid >> 2, wc = wid & 3, fr = lane & 15, fq = lane >> 4;
    unsigned voffA[2], voffB[2];
#pragma unroll
    for (int i = 0; i < 2; ++i) { int R, C; stage_rc(tid * 16 + i * 8192, R, C); const int Rb = (R & ~31) + perm32(R & 31);
        voffA[i] = (unsigned)(R * LD + C) * 2u; voffB[i] = (unsigned)(Rb * LD + C) * 2u; }
    const size_t kstep = (size_t)(BK * 2);
    const size_t hstep = (size_t)HALF * LD * 2;
    const size_t tstep = 2 * hstep;
    const size_t halfoff = (size_t)nt * BK * 2;
    const unsigned ldsw = (unsigned)wid * 1024u;
    const int aoff = lds_byte(wr * 64 + fr, fq * 8), boff = lds_byte(wc * 32 + fr, fq * 8);
#define PG8_SA(b, h) (((b) * 2 + (h)) * HTB)
#define PG8_SB(b, h) ((4 + (b) * 2 + (h)) * HTB)
#define PG8_STAGE(bufoff, gbase, voff) do { _Pragma("unroll") for (int _i = 0; _i < 2; ++_i) \
        __builtin_amdgcn_global_load_lds((const unsigned*)((const char*)(gbase) + (voff)[_i]), (LAS unsigned*)(lds + (bufoff) + ldsw + _i * 8192), 16, 0, 0); } while (0)
#define PG8_LDA(dst, b, h) do { _Pragma("unroll") for (int m = 0; m < 4; ++m) _Pragma("unroll") for (int k = 0; k < 2; ++k) dst[m][k] = *(const LAS bf16x8*)(lds + PG8_SA(b, h) + aoff + m * 2048 + k * 1024); } while (0)
#define PG8_LDB(dst, b, h) do { _Pragma("unroll") for (int n = 0; n < 2; ++n) _Pragma("unroll") for (int k = 0; k < 2; ++k) dst[n][k] = *(const LAS bf16x8*)(lds + PG8_SB(b, h) + boff + n * 2048 + k * 1024); } while (0)
#define PG8_MMA(ai, bj, At, Bt) do { __builtin_amdgcn_s_setprio(1); _Pragma("unroll") for (int m = 0; m < 4; ++m) _Pragma("unroll") for (int n = 0; n < 2; ++n) _Pragma("unroll") for (int k = 0; k < 2; ++k) \
        acc[ai][bj][m][n] = __builtin_amdgcn_mfma_f32_16x16x32_bf16(Bt[n][k], At[m][k], acc[ai][bj][m][n], 0, 0, 0); __builtin_amdgcn_s_setprio(0); } while (0)
#define PG8_WAIT_V(n) asm volatile("s_waitcnt vmcnt(" #n ")" ::: "memory")
#define PG8_WAIT_L(n) asm volatile("s_waitcnt lgkmcnt(" #n ")" ::: "memory")
#define PG8_BAR __builtin_amdgcn_s_barrier()
#define PG8_SCHED __builtin_amdgcn_sched_barrier(0)
    Unit cur, nxt; int ui = 0;
    if (!S.next(0, cur)) return;
    f32x4 acc[2][2][4][2];
#pragma unroll
    for (int a = 0; a < 2; ++a)
#pragma unroll
        for (int b = 0; b < 2; ++b)
#pragma unroll
            for (int m = 0; m < 4; ++m)
#pragma unroll
                for (int n = 0; n < 2; ++n) acc[a][b][m][n] = (f32x4){0.f, 0.f, 0.f, 0.f};
    bf16x8 At[4][2], B0[2][2], B1[2][2];
    const char* cA = (const char*)Abase + (size_t)cur.pm * tstep + (size_t)cur.half * halfoff; const char* cB = (const char*)Bbase + (size_t)cur.pn * tstep + (size_t)cur.half * halfoff;
    if constexpr (SP2) {
        PG8_STAGE(PG8_SB(0, 0), cB, voffB); PG8_STAGE(PG8_SB(0, 1), cB + hstep, voffB); PG8_STAGE(PG8_SA(0, 0), cA, voffA); PG8_STAGE(PG8_SA(0, 1), cA + hstep, voffA);
        if (wr == 1) PG8_BAR;
        PG8_WAIT_V(2); PG8_BAR;
        PG8_STAGE(PG8_SB(1, 0), cB + kstep, voffB); PG8_STAGE(PG8_SA(1, 0), cA + kstep, voffA); PG8_STAGE(PG8_SB(1, 1), cB + hstep + kstep, voffB);
        PG8_WAIT_V(6); PG8_BAR;
    } else {
        PG8_STAGE(PG8_SB(0, 0), cB, voffB); PG8_STAGE(PG8_SA(0, 0), cA, voffA); PG8_STAGE(PG8_SB(0, 1), cB + hstep, voffB); PG8_STAGE(PG8_SA(0, 1), cA + hstep, voffA);
        if (wr == 1) PG8_BAR;
        PG8_WAIT_V(4); PG8_BAR;
        PG8_STAGE(PG8_SB(1, 0), cB + kstep, voffB); PG8_STAGE(PG8_SA(1, 0), cA + kstep, voffA); PG8_STAGE(PG8_SB(1, 1), cB + hstep + kstep, voffB);
        PG8_WAIT_V(6); PG8_BAR;
    }
    for (;;) {
        const bool has_next = S.next(ui + 1, nxt);
        const char* nA = has_next ? (const char*)Abase + (size_t)nxt.pm * tstep + (size_t)nxt.half * halfoff : cA;
        const char* nB = has_next ? (const char*)Bbase + (size_t)nxt.pn * tstep + (size_t)nxt.half * halfoff : cB;
        for (int t = 0; t < nt; t += 2) {
            const bool last = (t == nt - 2);
            const char* a1 = cA + (size_t)(t + 1) * kstep;
            const char* a2 = last ? nA : cA + (size_t)(t + 2) * kstep; const char* b2 = last ? nB : cB + (size_t)(t + 2) * kstep;
            const char* a3 = a2 + kstep; const char* b3 = b2 + kstep;
            if constexpr (SP2) {
            PG8_LDB(B0, 0, 0); PG8_LDB(B1, 0, 1); PG8_SCHED; PG8_LDA(At, 0, 0); PG8_STAGE(PG8_SA(1, 1), a1 + hstep, voffA);
            PG8_WAIT_V(8); PG8_WAIT_L(0); PG8_BAR; PG8_MMA(0, 0, At, B0); PG8_MMA(0, 1, At, B1); PG8_BAR; PG8_SCHED;
            PG8_LDA(At, 0, 1); PG8_STAGE(PG8_SB(0, 0), b2, voffB); PG8_STAGE(PG8_SB(0, 1), b2 + hstep, voffB); PG8_STAGE(PG8_SA(0, 0), a2, voffA);
            PG8_WAIT_V(8); PG8_WAIT_L(0); PG8_BAR; PG8_MMA(1, 0, At, B0); PG8_MMA(1, 1, At, B1); PG8_BAR; PG8_SCHED;
            PG8_LDB(B0, 1, 0); PG8_LDB(B1, 1, 1); PG8_SCHED; PG8_LDA(At, 1, 0); PG8_STAGE(PG8_SA(0, 1), a2 + hstep, voffA);
            PG8_WAIT_V(8); PG8_WAIT_L(0); PG8_BAR; PG8_MMA(0, 0, At, B0); PG8_MMA(0, 1, At, B1); PG8_BAR; PG8_SCHED;
            PG8_LDA(At, 1, 1); PG8_STAGE(PG8_SB(1, 0), b3, voffB); PG8_STAGE(PG8_SB(1, 1), b3 + hstep, voffB); PG8_STAGE(PG8_SA(1, 0), a3, voffA);
            PG8_WAIT_V(8); PG8_WAIT_L(0); PG8_BAR; PG8_MMA(1, 0, At, B0); PG8_MMA(1, 1, At, B1); PG8_BAR; PG8_SCHED;
            } else {
            PG8_LDB(B0, 0, 0); PG8_SCHED; PG8_LDA(At, 0, 0); PG8_STAGE(PG8_SA(1, 1), a1 + hstep, voffA);
            PG8_WAIT_L(8); PG8_BAR; PG8_WAIT_L(0); PG8_MMA(0, 0, At, B0); PG8_BAR; PG8_SCHED;
            PG8_LDB(B1, 0, 1); PG8_STAGE(PG8_SB(0, 0), b2, voffB);
            PG8_BAR; PG8_WAIT_L(0); PG8_MMA(0, 1, At, B1); PG8_BAR;
            PG8_LDA(At, 0, 1); PG8_STAGE(PG8_SA(0, 0), a2, voffA);
            PG8_BAR; PG8_WAIT_L(0); PG8_MMA(1, 0, At, B0); PG8_BAR; PG8_SCHED;
            PG8_STAGE(PG8_SB(0, 1), b2 + hstep, voffB);
            PG8_WAIT_V(6); PG8_BAR; PG8_MMA(1, 1, At, B1); PG8_BAR;
            PG8_LDB(B0, 1, 0); PG8_SCHED; PG8_LDA(At, 1, 0); PG8_STAGE(PG8_SA(0, 1), a2 + hstep, voffA);
            PG8_WAIT_L(8); PG8_BAR; PG8_WAIT_L(0); PG8_MMA(0, 0, At, B0); PG8_BAR; PG8_SCHED;
            PG8_LDB(B1, 1, 1); PG8_STAGE(PG8_SB(1, 0), b3, voffB);
            PG8_BAR; PG8_WAIT_L(0); PG8_MMA(0, 1, At, B1); PG8_BAR;
            PG8_LDA(At, 1, 1); PG8_STAGE(PG8_SA(1, 0), a3, voffA);
            PG8_BAR; PG8_WAIT_L(0); PG8_MMA(1, 0, At, B0); PG8_BAR; PG8_SCHED;
            PG8_STAGE(PG8_SB(1, 1), b3 + hstep, voffB);
            PG8_WAIT_V(6); PG8_BAR; PG8_MMA(1, 1, At, B1); PG8_BAR;
            }
        }
        if constexpr (ALIGN_EPI) { if (wr == 0) PG8_BAR; }
        E(acc, cur, wr, wc, fr, fq);
        if (!has_next) break;
        if (!E.keep(cur)) {
#pragma unroll
            for (int a = 0; a < 2; ++a)
#pragma unroll
                for (int b = 0; b < 2; ++b)
#pragma unroll
                    for (int m = 0; m < 4; ++m)
#pragma unroll
                        for (int n = 0; n < 2; ++n) acc[a][b][m][n] = (f32x4){0.f, 0.f, 0.f, 0.f};
        }
        cur = nxt; cA = nA; cB = nB; ++ui;
        if constexpr (ALIGN_EPI) { if (wr == 1) PG8_BAR; }
    }
    PG8_WAIT_V(0);
    if constexpr (!ALIGN_EPI) { if (wr == 0) PG8_BAR; }
    PG8_BAR;
#undef PG8_SA
#undef PG8_SB
#undef PG8_STAGE
#undef PG8_LDA
#undef PG8_LDB
#undef PG8_MMA
#undef PG8_WAIT_V
#undef PG8_WAIT_L
#undef PG8_BAR
#undef PG8_SCHED
}

struct EpiProj {
    bf16_t* O; bf16_t* GR; bf16_t* GB; float* KM;
    __device__ __forceinline__ bool keep(const Unit&) const { return false; }
    __device__ __forceinline__ void operator()(f32x4 (&acc)[2][2][4][2], const Unit& u, int wr, int wc, int fr, int fq) const {
        if (u.pn >= 20 && u.pn < 24) {
#pragma unroll
            for (int bj = 0; bj < 2; ++bj)
#pragma unroll
                for (int n = 0; n < 2; ++n)
#pragma unroll
                    for (int j = 0; j < 4; ++j) { float sm = 0.f;
#pragma unroll
                        for (int ai = 0; ai < 2; ++ai)
#pragma unroll
                            for (int m = 0; m < 4; ++m) sm += acc[ai][bj][m][n][j];
                        sm += __shfl_xor(sm, 1); sm += __shfl_xor(sm, 2); sm += __shfl_xor(sm, 4); sm += __shfl_xor(sm, 8);
                        if (fr == 0) { const int colr = (u.pn - 20) * 256 + bj * 128 + wc * 32 + 8 * fq + 4 * n + j;
                            atomicAdd(KM + ((size_t)((u.pm >> 3) * 8 + (colr >> 7)) * 8 + (u.pm & 7)) * 128 + (colr & 127), sm * (1.0f / 256.0f)); } }
        }
        if (u.pn >= 32) {
            const size_t tbase = ((size_t)(u.pm * 16 + (u.pn - 32)) * 8) * 512 + threadIdx.x;
#pragma unroll
            for (int ai = 0; ai < 2; ++ai)
#pragma unroll
                for (int m = 0; m < 4; ++m) { float r[8], g[8];
#pragma unroll
                    for (int n = 0; n < 2; ++n)
#pragma unroll
                        for (int j = 0; j < 4; ++j) { const float ea = __expf(fminf(-acc[ai][0][m][n][j], 80.f)), eb = __expf(fminf(-acc[ai][1][m][n][j], 80.f));
                            const float sb = __builtin_amdgcn_rcpf(1.0f + eb); g[n * 4 + j] = sb; r[n * 4 + j] = __builtin_amdgcn_rcpf(1.0f + ea) * (1.0f + eb); }
                    u32x4 wr_, wg_; wr_.x = cvt_pk_bf16(r[0], r[1]); wr_.y = cvt_pk_bf16(r[2], r[3]); wr_.z = cvt_pk_bf16(r[4], r[5]); wr_.w = cvt_pk_bf16(r[6], r[7]);
                    wg_.x = cvt_pk_bf16(g[0], g[1]); wg_.y = cvt_pk_bf16(g[2], g[3]); wg_.z = cvt_pk_bf16(g[4], g[5]); wg_.w = cvt_pk_bf16(g[6], g[7]);
                    const size_t o = (tbase + (size_t)(ai * 4 + m) * 512) * 8;
                    *(u32x4*)(GR + o) = wr_; *(u32x4*)(GB + o) = wg_; }
            return;
        }
        const int row0 = u.pm * BM + wr * 64 + fr, col0 = u.pn * BM + wc * 32 + 8 * fq;
        const int act = ((u.pn >= 12 && u.pn < 16) || (u.pn >= 28)) ? 1 : 0;
#pragma unroll
        for (int ai = 0; ai < 2; ++ai)
#pragma unroll
            for (int m = 0; m < 4; ++m) { bf16_t* rowp = O + (size_t)(row0 + ai * HALF + m * 16) * NPROJ + col0;
#pragma unroll
                for (int bj = 0; bj < 2; ++bj) { f32x4 v0 = acc[ai][bj][m][0], v1 = acc[ai][bj][m][1];
                    if (act == 1) {
#pragma unroll
                        for (int j = 0; j < 4; ++j) { v0[j] = siluf_(v0[j]); v1[j] = siluf_(v1[j]); } }
                    u32x4 w; w.x = cvt_pk_bf16(v0[0], v0[1]); w.y = cvt_pk_bf16(v0[2], v0[3]); w.z = cvt_pk_bf16(v1[0], v1[1]); w.w = cvt_pk_bf16(v1[2], v1[3]);
                    *(u32x4*)(rowp + bj * HALF) = w; } }
    }
};
struct EpiMerge {
    const bf16_t* GR; const bf16_t* GB; bf16_t* O;
    __device__ __forceinline__ bool keep(const Unit& u) const { return u.half == 0; }
    __device__ __forceinline__ void operator()(f32x4 (&acc)[2][2][4][2], const Unit& u, int wr, int wc, int fr, int fq) const {
        const int row0 = u.pm * BM + wr * 64 + fr, col0 = u.pn * BM + wc * 32 + 8 * fq;
        const bf16_t* G = (u.half == 0) ? GR : GB;
#pragma unroll
        for (int ai = 0; ai < 2; ++ai) {
            u32x4 gv[4][2];
#pragma unroll
            for (int m = 0; m < 4; ++m)
#pragma unroll
                for (int bj = 0; bj < 2; ++bj)
                    gv[m][bj] = *(const u32x4*)(G + ((((size_t)(u.pm * 16 + u.pn * 2 + bj) * 8) + ai * 4 + m) * 512 + threadIdx.x) * 8);
#pragma unroll
            for (int m = 0; m < 4; ++m)
#pragma unroll
                for (int bj = 0; bj < 2; ++bj) { const size_t row = (size_t)(row0 + ai * HALF + m * 16); const int col = col0 + bj * HALF;
                    const u32x4 gb = gv[m][bj];
                    const float fb[8] = {bflo(gb.x), bfhi(gb.x), bflo(gb.y), bfhi(gb.y), bflo(gb.z), bfhi(gb.z), bflo(gb.w), bfhi(gb.w)};
                    if (u.half == 0) {
#pragma unroll
                        for (int j = 0; j < 4; ++j) { acc[ai][bj][m][0][j] *= fb[j]; acc[ai][bj][m][1][j] *= fb[4 + j]; }
                    } else {
                        f32x4 v0 = acc[ai][bj][m][0], v1 = acc[ai][bj][m][1];
#pragma unroll
                        for (int j = 0; j < 4; ++j) { v0[j] *= fb[j]; v1[j] *= fb[4 + j]; }
                        u32x4 w; w.x = cvt_pk_bf16(v0[0], v0[1]); w.y = cvt_pk_bf16(v0[2], v0[3]); w.z = cvt_pk_bf16(v1[0], v1[1]); w.w = cvt_pk_bf16(v1[2], v1[3]);
                        *(u32x4*)(O + row * DM + col) = w;
                    } }
        }
    }
};
struct EpiY {
    bf16_t* Y; float* RSS;
    __device__ __forceinline__ bool keep(const Unit&) const { return false; }
    __device__ __forceinline__ void operator()(f32x4 (&acc)[2][2][4][2], const Unit& u, int wr, int wc, int fr, int fq) const {
        const int row0 = u.pm * BM + wr * 64 + fr, col0 = u.pn * BM + wc * 32 + 8 * fq;
#pragma unroll
        for (int ai = 0; ai < 2; ++ai)
#pragma unroll
            for (int m = 0; m < 4; ++m) { const size_t row = (size_t)(row0 + ai * HALF + m * 16); float ss = 0.f;
#pragma unroll
                for (int bj = 0; bj < 2; ++bj) { const f32x4 v0 = acc[ai][bj][m][0], v1 = acc[ai][bj][m][1];
#pragma unroll
                    for (int j = 0; j < 4; ++j) ss += v0[j] * v0[j] + v1[j] * v1[j];
                    u32x4 w; w.x = cvt_pk_bf16(v0[0], v0[1]); w.y = cvt_pk_bf16(v0[2], v0[3]); w.z = cvt_pk_bf16(v1[0], v1[1]); w.w = cvt_pk_bf16(v1[2], v1[3]);
                    *(u32x4*)(Y + row * DM + col0 + bj * HALF) = w; }
                ss += __shfl_xor(ss, 16); ss += __shfl_xor(ss, 32);
                if (fq == 0) RSS[row * 32 + u.pn * 4 + wc] = ss; }
    }
};
}

__device__ __forceinline__ void phase_prep(const Params& p, unsigned char* smem) {
    const int tid = threadIdx.x, wid = tid >> 6, lane = tid & 63;
    {
        float* T = (float*)smem;
        auto decode = [&](int t, const float*& src, bf16_t*& dst, int& ld) {
            if (t < 6144) { const int kt = t / 192, ntile = t % 192; const int n0 = ntile * 64; int sc = n0 < 4096 ? n0 : n0 + 16;
                if (n0 >= 8192) { const int rel = n0 - 8192, tl = rel >> 8, j0 = rel & 255; sc = ((j0 >> 7) ? 10256 : 8208) + tl * 128 + (j0 & 127); }
                src = p.w_in + (size_t)(kt * 64) * INW + sc; ld = INW; dst = p.WinT + (size_t)n0 * 2048 + kt * 64; }
            else if (t < 7168) { const int t2 = t - 6144, kt = t2 >> 5, ntile = t2 & 31; const int k0 = kt * 64;
                src = (k0 < 1024 ? p.w_a + (size_t)k0 * 2048 : p.w_b + (size_t)(k0 - 1024) * 2048) + ntile * 64; ld = 2048; dst = p.WabT + (size_t)(ntile * 64) * 2048 + k0; }
            else { const int t3 = t - 7168, kt = t3 >> 5, ntile = t3 & 31;
                src = p.w_out + (size_t)(kt * 64) * 2048 + ntile * 64; ld = 2048; dst = p.WoT + (size_t)(ntile * 64) * 2048 + kt * 64; }
        };
        float4 v[4][2], vn[4][2];
        int t0 = blockIdx.x * 4;
        if (t0 < 8192) {
#pragma unroll
            for (int u = 0; u < 4; ++u) { const float* src; bf16_t* dst; int ld; decode(t0 + u, src, dst, ld);
#pragma unroll
                for (int rep = 0; rep < 2; ++rep) v[u][rep] = *(const float4*)(src + (size_t)((tid >> 4) + rep * 32) * ld + (tid & 15) * 4); } }
#pragma unroll 1
        for (; t0 < 8192; t0 += gridDim.x * 4) {
            const int tn = t0 + (int)gridDim.x * 4;
            if (tn < 8192) {
#pragma unroll
                for (int u = 0; u < 4; ++u) { const float* src; bf16_t* dst; int ld; decode(tn + u, src, dst, ld);
#pragma unroll
                    for (int rep = 0; rep < 2; ++rep) vn[u][rep] = *(const float4*)(src + (size_t)((tid >> 4) + rep * 32) * ld + (tid & 15) * 4); } }
            lds_sync();
#pragma unroll
            for (int u = 0; u < 4; ++u)
#pragma unroll
                for (int rep = 0; rep < 2; ++rep) { float* tp = T + u * 4160 + ((tid >> 4) + rep * 32) * 65 + (tid & 15) * 4;
                    tp[0] = v[u][rep].x; tp[1] = v[u][rep].y; tp[2] = v[u][rep].z; tp[3] = v[u][rep].w; }
            lds_sync();
#pragma unroll
            for (int u = 0; u < 4; ++u) { const int n = tid >> 3, kc = (tid & 7) * 8; const float* tp = T + u * 4160; u32x4 w;
                const float* src; bf16_t* dst; int ld; decode(t0 + u, src, dst, ld);
                w.x = pk2(tp[(kc + 0) * 65 + n], tp[(kc + 1) * 65 + n]); w.y = pk2(tp[(kc + 2) * 65 + n], tp[(kc + 3) * 65 + n]);
                w.z = pk2(tp[(kc + 4) * 65 + n], tp[(kc + 5) * 65 + n]); w.w = pk2(tp[(kc + 6) * 65 + n], tp[(kc + 7) * 65 + n]);
                *(u32x4*)(dst + (size_t)n * 2048 + kc) = w; }
#pragma unroll
            for (int u = 0; u < 4; ++u) { v[u][0] = vn[u][0]; v[u][1] = vn[u][1]; }
        }
        lds_sync();
    }
    for (int i = blockIdx.x * NTHR + tid; i < 65536; i += gridDim.x * NTHR) p.KMEAN[i] = 0.f;
    float* Wsm = (float*)smem;
    for (int i = tid; i < 8192; i += NTHR) { const int k = i >> 2, g = i & 3; const int slot = ((k >> 8) * 4 + (k & 3)) * 64 + ((k >> 2) & 63);
        *(float4*)&Wsm[slot * 16 + 4 * ((g + (slot >> 2)) & 3)] = *(const float4*)&p.w_in[(size_t)k * INW + 4096 + g * 4]; }
    __syncthreads();
    for (int it = blockIdx.x; it < 1024; it += gridDim.x) {
        const int row0 = it * 16 + wid * 2;
        float ss0 = 0.f, ss1 = 0.f;
        float acc[2][16];
#pragma unroll
        for (int rr = 0; rr < 2; ++rr)
#pragma unroll
            for (int c = 0; c < 16; ++c) acc[rr][c] = 0.f;
        float4 xa[8], xb[8];
#pragma unroll
        for (int i = 0; i < 8; ++i) { xa[i] = *(const float4*)(p.x + (size_t)row0 * DM + i * 256 + lane * 4); xb[i] = *(const float4*)(p.x + (size_t)(row0 + 1) * DM + i * 256 + lane * 4); }
#pragma unroll 1
        for (int i = 0; i < 8; ++i) {
            const float4 w = *(const float4*)(p.pre_w + i * 256 + lane * 4);
            float4 a = xa[0], b = xb[0];
#pragma unroll
            for (int q = 1; q < 8; ++q) { if (i == q) { a = xa[q]; b = xb[q]; } }
            ss0 += a.x * a.x + a.y * a.y + a.z * a.z + a.w * a.w; ss1 += b.x * b.x + b.y * b.y + b.z * b.z + b.w * b.w;
            const float xav[4] = {a.x * w.x, a.y * w.y, a.z * w.z, a.w * w.w}, xbv[4] = {b.x * w.x, b.y * w.y, b.z * w.z, b.w * w.w};
#pragma unroll
            for (int j = 0; j < 4; ++j) { const int slot = (i * 4 + j) * 64 + lane;
#pragma unroll
                for (int g = 0; g < 4; ++g) { const float4 wv = *(const float4*)&Wsm[slot * 16 + 4 * ((g + (slot >> 2)) & 3)];
                    acc[0][g * 4 + 0] += xav[j] * wv.x; acc[0][g * 4 + 1] += xav[j] * wv.y; acc[0][g * 4 + 2] += xav[j] * wv.z; acc[0][g * 4 + 3] += xav[j] * wv.w;
                    acc[1][g * 4 + 0] += xbv[j] * wv.x; acc[1][g * 4 + 1] += xbv[j] * wv.y; acc[1][g * 4 + 2] += xbv[j] * wv.z; acc[1][g * 4 + 3] += xbv[j] * wv.w; } }
        }
        ss0 = wave_sum(ss0); ss1 = wave_sum(ss1);
        const float rs0 = rsqrtf(ss0 * (1.0f / 2048.0f) + 1e-6f), rs1 = rsqrtf(ss1 * (1.0f / 2048.0f) + 1e-6f);
#pragma unroll
        for (int i = 0; i < 8; ++i) {
            const float4 w = *(const float4*)(p.pre_w + i * 256 + lane * 4);
            const float4 a = xa[i], b = xb[i];
            u32x2 o; o.x = pk2(a.x * rs0 * w.x, a.y * rs0 * w.y); o.y = pk2(a.z * rs0 * w.z, a.w * rs0 * w.w);
            *(u32x2*)(p.H + (size_t)row0 * DM + i * 256 + lane * 4) = o;
            o.x = pk2(b.x * rs1 * w.x, b.y * rs1 * w.y); o.y = pk2(b.z * rs1 * w.z, b.w * rs1 * w.w);
            *(u32x2*)(p.H + (size_t)(row0 + 1) * DM + i * 256 + lane * 4) = o;
        }
#pragma unroll
        for (int rr = 0; rr < 2; ++rr) {
            float mine = 0.f;
#pragma unroll
            for (int c = 0; c < 16; ++c) { const float s = wave_sum(acc[rr][c]); mine = (lane == c) ? s : mine; }
            mine *= (rr == 0 ? rs0 : rs1);
            if (lane < 16) { const int row = row0 + rr, b = row >> 11, s = row & 2047;
                if (lane < 8) p.BETA[(size_t)(b * 8 + lane) * SEQ + s] = 1.0f / (1.0f + expf(-mine));
                else { const int hh = lane - 8; const float a = mine + p.dt_bias[hh]; const float sp = fmaxf(a, 0.f) + log1pf(expf(-fabsf(a)));
                    p.G[(size_t)(b * 8 + hh) * SEQ + s] = -expf(p.a_log[hh]) * sp; } }
        }
    }
}

__device__ __forceinline__ void phase_kmean(const Params& p, unsigned char* smem) {
    const int tid = threadIdx.x;
    float* red = (float*)smem;
    for (int task = blockIdx.x; task < 512; task += gridDim.x) {
        const int blk = task & 7, h = (task >> 3) & 7, b = task >> 6;
        const int dpair = tid & 63, sl = tid >> 6;
        const bf16_t* src = p.PROJ + (size_t)(b * SEQ + blk * 256 + sl * 32) * NPROJ + 4096 + 1024 + h * 128 + dpair * 2;
        float s0 = 0.f, s1 = 0.f;
#pragma unroll 8
        for (int i = 0; i < 32; ++i) { const unsigned w = *(const unsigned*)(src + (size_t)i * NPROJ); s0 += bflo(w); s1 += bfhi(w); }
        __syncthreads();
        red[sl * 128 + dpair * 2] = s0; red[sl * 128 + dpair * 2 + 1] = s1;
        __syncthreads();
        if (tid < 128) { float s = 0.f;
#pragma unroll
            for (int i = 0; i < 8; ++i) s += red[i * 128 + tid];
            p.KMEAN[(size_t)task * 128 + tid] = s * (1.0f / 256.0f); }
    }
}

__device__ __forceinline__ void gdn_naive(const Params& p, unsigned char* smem, int bh) {
    const int tid = threadIdx.x, e = tid & 127, dp = tid >> 7;
    bf16_t* sq = (bf16_t*)smem;
    bf16_t* sk = sq + 64 * 128;
    bf16_t* sv = sk + 64 * 128;
    float* sg = (float*)(smem + 49152);
    float* sb = sg + 64;
    float* red1 = sb + 64;
    float* red2 = red1 + 1024;
    float Sreg[32];
#pragma unroll
    for (int d = 0; d < 32; ++d) Sreg[d] = 0.f;
    const size_t base = (size_t)bh * SEQ * 128;
    const int b = bh >> 3, h = bh & 7;
    for (int ch = 0; ch < 32; ++ch) {
        __syncthreads();
#pragma unroll
        for (int i = 0; i < 2; ++i) { const int idx = tid + i * NTHR; const size_t g = base + (size_t)ch * 64 * 128 + (size_t)idx * 8;
            *(u32x4*)(sq + idx * 8) = *(const u32x4*)(p.GQ + g); *(u32x4*)(sk + idx * 8) = *(const u32x4*)(p.GK + g); *(u32x4*)(sv + idx * 8) = *(const u32x4*)(p.GV + g); }
        if (tid < 64) { sg[tid] = expf(p.G[(size_t)bh * SEQ + ch * 64 + tid]); sb[tid] = p.BETA[(size_t)bh * SEQ + ch * 64 + tid]; }
        __syncthreads();
        for (int t = 0; t < 64; ++t) {
            const int buf = t & 1;
            float kk[32], qq[32];
#pragma unroll
            for (int i = 0; i < 4; ++i) { const u32x4 kw = *(const u32x4*)(sk + t * 128 + dp * 32 + i * 8); const u32x4 qw = *(const u32x4*)(sq + t * 128 + dp * 32 + i * 8);
                kk[i * 8 + 0] = bflo(kw.x); kk[i * 8 + 1] = bfhi(kw.x); kk[i * 8 + 2] = bflo(kw.y); kk[i * 8 + 3] = bfhi(kw.y); kk[i * 8 + 4] = bflo(kw.z); kk[i * 8 + 5] = bfhi(kw.z); kk[i * 8 + 6] = bflo(kw.w); kk[i * 8 + 7] = bfhi(kw.w);
                qq[i * 8 + 0] = bflo(qw.x); qq[i * 8 + 1] = bfhi(qw.x); qq[i * 8 + 2] = bflo(qw.y); qq[i * 8 + 3] = bfhi(qw.y); qq[i * 8 + 4] = bflo(qw.z); qq[i * 8 + 5] = bfhi(qw.z); qq[i * 8 + 6] = bflo(qw.w); qq[i * 8 + 7] = bfhi(qw.w); }
            float part = 0.f;
#pragma unroll
            for (int d = 0; d < 32; ++d) part += Sreg[d] * kk[d];
            red1[(buf * 4 + dp) * 128 + e] = part;
            __syncthreads();
            if (dp == 0 && t > 0) { const int pb = buf ^ 1; const float o = red2[(pb * 4 + 0) * 128 + e] + red2[(pb * 4 + 1) * 128 + e] + red2[(pb * 4 + 2) * 128 + e] + red2[(pb * 4 + 3) * 128 + e];
                p.ORAW[(size_t)(b * SEQ + ch * 64 + t - 1) * 1024 + h * 128 + e] = f2bf(o); }
            const float eg = sg[t];
            const float Sk = (red1[(buf * 4 + 0) * 128 + e] + red1[(buf * 4 + 1) * 128 + e] + red1[(buf * 4 + 2) * 128 + e] + red1[(buf * 4 + 3) * 128 + e]) * eg;
            const float delta = sb[t] * (bf2f(sv[t * 128 + e]) - Sk);
            float po = 0.f;
#pragma unroll
            for (int d = 0; d < 32; ++d) { Sreg[d] = eg * Sreg[d] + kk[d] * delta; po += Sreg[d] * qq[d]; }
            red2[(buf * 4 + dp) * 128 + e] = po;
        }
        __syncthreads();
        if (dp == 0) { const float o = red2[(4 + 0) * 128 + e] + red2[(4 + 1) * 128 + e] + red2[(4 + 2) * 128 + e] + red2[(4 + 3) * 128 + e];
            p.ORAW[(size_t)(b * SEQ + ch * 64 + 63) * 1024 + h * 128 + e] = f2bf(o); }
    }
}

__device__ __forceinline__ void moba_task(const Params& p, unsigned char* smem, int bh, int qb) {
    int tid_o = threadIdx.x; asm volatile("" : "+v"(tid_o));
    const int tid = tid_o, wid = tid >> 6, lane = tid & 63, r16 = lane & 15, q4 = lane >> 4;
    bf16_t* Ks0 = (bf16_t*)smem;
    constexpr int KVB = 64 * 136 + 128 * 72;
    unsigned* sel = (unsigned*)(Ks0 + 2 * KVB);
    const int b = bh >> 3, h = bh & 7, t0 = qb * 256;
    const bf16_t* Pq = p.PROJ + (size_t)b * SEQ * NPROJ + 4096 + h * 128;
    const bf16_t* Pk = Pq + 1024; const bf16_t* Pv = Pq + 2048;
    lds_sync();
    const int n_own = 4, n_it = n_own + qb * 4;
    u32x4 pk_[2], pv_[2];
#define MOBA_ISSUE(IT) do { const int it_ = (IT); const bool own_ = it_ < n_own; const int blk_ = own_ ? qb : ((it_ - n_own) >> 2); const int kt_ = own_ ? it_ : ((it_ - n_own) & 3); \
        const int key0_ = blk_ * 256 + kt_ * 64; \
        _Pragma("unroll") for (int i_ = 0; i_ < 2; ++i_) { const int pc_ = tid + i_ * NTHR; \
            pk_[i_] = *(const u32x4*)(Pk + (size_t)(key0_ + (pc_ >> 4)) * NPROJ + (pc_ & 15) * 8); \
            pv_[i_] = *(const u32x4*)(Pv + (size_t)(key0_ + (pc_ & 63)) * NPROJ + (pc_ >> 6) * 8); } } while (0)
    MOBA_ISSUE(0);
    float* kml = (float*)(sel + 256) + 2048;
    if (tid < 256) *(float4*)&kml[tid * 4] = *(const float4*)(p.KMEAN + (size_t)bh * 1024 + tid * 4);
    lds_sync();
#pragma unroll 1
    for (int pass = 0; pass < 2; ++pass) {
        const int qi = (tid >> 2) + pass * 128, part = tid & 3;
        float qv[32];
        const bf16_t* qr = Pq + (size_t)(t0 + qi) * NPROJ + part * 32;
#pragma unroll
        for (int i = 0; i < 4; ++i) { const u32x4 w = *(const u32x4*)(qr + i * 8);
            qv[i * 8 + 0] = bflo(w.x); qv[i * 8 + 1] = bfhi(w.x); qv[i * 8 + 2] = bflo(w.y); qv[i * 8 + 3] = bfhi(w.y); qv[i * 8 + 4] = bflo(w.z); qv[i * 8 + 5] = bfhi(w.z); qv[i * 8 + 6] = bflo(w.w); qv[i * 8 + 7] = bfhi(w.w); }
        float* gl = (float*)(sel + 256);
#pragma unroll 1
        for (int j = 0; j < 7; ++j) { const float* km = kml + j * 128 + part * 32; float s = 0.f;
#pragma unroll
                for (int i = 0; i < 8; ++i) { const float4 kv = *(const float4*)(km + i * 4); s += qv[i * 4] * kv.x + qv[i * 4 + 1] * kv.y + qv[i * 4 + 2] * kv.z + qv[i * 4 + 3] * kv.w; }
                s += __shfl_xor(s, 1); s += __shfl_xor(s, 2); if (part == 0) gl[qi * 8 + j] = (j < qb) ? s : -3.0e38f; }
        unsigned m = 0;
        if (part == 0) {
            float gate[7];
#pragma unroll
            for (int j = 0; j < 7; ++j) gate[j] = gl[qi * 8 + j];
            if (qb <= 3) m = (1u << qb) - 1u;
            else {
#pragma unroll
                for (int r = 0; r < 3; ++r) { float best = -3.0e38f; int bi = 0;
#pragma unroll
                    for (int j = 0; j < 7; ++j) if (j < qb && !((m >> j) & 1u) && gate[j] > best) { best = gate[j]; bi = j; }
                    m |= 1u << bi; } }
        }
        if (part == 0) sel[qi] = m;
    }
    lds_sync();
    unsigned mysel[2]; int qpos[2];
    bf16x8 qf[2][4];
#pragma unroll
    for (int u = 0; u < 2; ++u) { const int myq = wid * 32 + u * 16 + r16; mysel[u] = sel[myq]; qpos[u] = myq;
        const bf16_t* qr = Pq + (size_t)(t0 + myq) * NPROJ + q4 * 8;
#pragma unroll
        for (int ks = 0; ks < 4; ++ks) { const u32x4 qw = *(const u32x4*)(qr + ks * 32);
            union { bf16x8 v; unsigned w[4]; } qs; const float scq = 0.08838834764831845f * 1.4426950408889634f;
            qs.w[0] = cvt_pk_bf16(bflo(qw.x) * scq, bfhi(qw.x) * scq); qs.w[1] = cvt_pk_bf16(bflo(qw.y) * scq, bfhi(qw.y) * scq);
            qs.w[2] = cvt_pk_bf16(bflo(qw.z) * scq, bfhi(qw.z) * scq); qs.w[3] = cvt_pk_bf16(bflo(qw.w) * scq, bfhi(qw.w) * scq);
            qf[u][ks] = qs.v; } }
    f32x4 O[2][8];
#pragma unroll
    for (int u = 0; u < 2; ++u)
#pragma unroll
        for (int mt = 0; mt < 8; ++mt) O[u][mt] = (f32x4){0.f, 0.f, 0.f, 0.f};
    float m_run[2] = {-1.0e30f, -1.0e30f}, l_run[2] = {0.f, 0.f};
    const float sc = 0.08838834764831845f * 1.4426950408889634f;
#define MOBA_WRITE(BUF) do { bf16_t* Kw_ = Ks0 + (BUF) * KVB; bf16_t* Vw_ = Kw_ + 64 * 136; \
        _Pragma("unroll") for (int i = 0; i < 2; ++i) { const int pc = tid + i * NTHR; \
            *(u32x4*)(Kw_ + (pc >> 4) * 136 + (pc & 15) * 8) = pk_[i]; \
            const u32x4 vv = pv_[i]; bf16_t* vt = Vw_ + ((pc >> 6) * 8) * 72 + (pc & 63); \
            vt[0 * 72] = (bf16_t)(vv.x & 0xffff); vt[1 * 72] = (bf16_t)(vv.x >> 16); vt[2 * 72] = (bf16_t)(vv.y & 0xffff); vt[3 * 72] = (bf16_t)(vv.y >> 16); \
            vt[4 * 72] = (bf16_t)(vv.z & 0xffff); vt[5 * 72] = (bf16_t)(vv.z >> 16); vt[6 * 72] = (bf16_t)(vv.w & 0xffff); vt[7 * 72] = (bf16_t)(vv.w >> 16); } } while (0)
    MOBA_WRITE(0);
    MOBA_ISSUE(1);
    lds_sync();
#pragma unroll 1
    for (int it = 0; it < n_it; ++it) {
        const bool own = it < n_own;
        const int blk = own ? qb : ((it - n_own) >> 2);
        const int kt = own ? it : ((it - n_own) & 3);
        if (it + 1 < n_it) { MOBA_WRITE((it + 1) & 1); if (it + 2 < n_it) MOBA_ISSUE(it + 2); }
        const bf16_t* Ks = Ks0 + (it & 1) * KVB; const bf16_t* VT = Ks + 64 * 136;
        const bool skip = own && (kt * 64 > wid * 32 + 31);
        if (!skip) {
            float offv[2];
#pragma unroll
            for (int u = 0; u < 2; ++u) { const bool okr = own || (((mysel[u] >> blk) & 1u) != 0u); offv[u] = okr ? fmaxf(m_run[u], -1.0e4f) : 3.0e38f; }
            f32x4 s[2][4];
#pragma unroll
            for (int nt = 0; nt < 4; ++nt) { s[0][nt] = (f32x4){-offv[0], -offv[0], -offv[0], -offv[0]}; s[1][nt] = (f32x4){-offv[1], -offv[1], -offv[1], -offv[1]};
#pragma unroll
                for (int ks = 0; ks < 4; ++ks) { const bf16x8 a = *(const bf16x8*)(Ks + (nt * 16 + r16) * 136 + ks * 32 + q4 * 8);
                    s[0][nt] = __builtin_amdgcn_mfma_f32_16x16x32_bf16(a, qf[0][ks], s[0][nt], 0, 0, 0);
                    s[1][nt] = __builtin_amdgcn_mfma_f32_16x16x32_bf16(a, qf[1][ks], s[1][nt], 0, 0, 0); } }
            union { bf16x8 v; unsigned w[4]; } pb[2][2];
#pragma unroll
            for (int u = 0; u < 2; ++u) {
                float tmax = -3.0e38f;
                if (own) {
#pragma unroll
                    for (int nt = 0; nt < 4; ++nt)
#pragma unroll
                        for (int j = 0; j < 4; ++j) { const int kin = kt * 64 + nt * 16 + q4 * 4 + j; const float xv = (kin <= qpos[u]) ? s[u][nt][j] : -3.0e38f; s[u][nt][j] = xv; tmax = fmaxf(tmax, xv); }
                } else {
#pragma unroll
                    for (int nt = 0; nt < 4; ++nt)
#pragma unroll
                        for (int j = 0; j < 4; ++j) tmax = fmaxf(tmax, s[u][nt][j]);
                }
                tmax = fmaxf(tmax, __shfl_xor(tmax, 16)); tmax = fmaxf(tmax, __shfl_xor(tmax, 32));
                if (!__all(tmax <= 6.0f)) {
                    const float d = fmaxf(tmax, 0.f);
                    const float m_new = (m_run[u] < -1.0e29f) ? (offv[u] + d) : (m_run[u] + d);
                    const float alpha = __builtin_amdgcn_exp2f(m_run[u] - m_new);
                    m_run[u] = m_new; l_run[u] *= alpha;
#pragma unroll
                    for (int mt = 0; mt < 8; ++mt) { O[u][mt][0] *= alpha; O[u][mt][1] *= alpha; O[u][mt][2] *= alpha; O[u][mt][3] *= alpha; }
#pragma unroll
                    for (int nt = 0; nt < 4; ++nt) { s[u][nt][0] -= d; s[u][nt][1] -= d; s[u][nt][2] -= d; s[u][nt][3] -= d; }
                }
                float psum = 0.f;
#pragma unroll
                for (int nt = 0; nt < 4; ++nt)
#pragma unroll
                    for (int j = 0; j < 4; ++j) { const float pv = __builtin_amdgcn_exp2f(s[u][nt][j]); s[u][nt][j] = pv; psum += pv; }
                l_run[u] += psum;
#pragma unroll
                for (int kk = 0; kk < 2; ++kk) {
                    pb[u][kk].w[0] = cvt_pk_bf16(s[u][2 * kk][0], s[u][2 * kk][1]); pb[u][kk].w[1] = cvt_pk_bf16(s[u][2 * kk][2], s[u][2 * kk][3]);
                    pb[u][kk].w[2] = cvt_pk_bf16(s[u][2 * kk + 1][0], s[u][2 * kk + 1][1]); pb[u][kk].w[3] = cvt_pk_bf16(s[u][2 * kk + 1][2], s[u][2 * kk + 1][3]); }
            }
#pragma unroll
            for (int kk = 0; kk < 2; ++kk)
#pragma unroll
                for (int mt = 0; mt < 8; ++mt) { const bf16_t* vr = VT + (mt * 16 + r16) * 72 + kk * 32 + q4 * 4;
                    union { bf16x8 v; u32x2 h[2]; } av; av.h[0] = *(const u32x2*)vr; av.h[1] = *(const u32x2*)(vr + 16);
                    O[0][mt] = __builtin_amdgcn_mfma_f32_16x16x32_bf16(av.v, pb[0][kk].v, O[0][mt], 0, 0, 0);
                    O[1][mt] = __builtin_amdgcn_mfma_f32_16x16x32_bf16(av.v, pb[1][kk].v, O[1][mt], 0, 0, 0); }
        }
        lds_sync();
    }
#undef MOBA_ISSUE
#undef MOBA_WRITE
#pragma unroll
    for (int u = 0; u < 2; ++u) {
        float l = l_run[u]; l += __shfl_xor(l, 16); l += __shfl_xor(l, 32);
        const float inv = 1.0f / l;
        const size_t tok = (size_t)b * SEQ + t0 + wid * 32 + u * 16 + r16;
#pragma unroll
        for (int mt = 0; mt < 8; ++mt) { const int d0 = mt * 16 + q4 * 4;
            const u32x2 zw = *(const u32x2*)(p.PROJ + tok * NPROJ + 7168 + h * 128 + d0);
            u32x2 o; o.x = pk2(O[u][mt][0] * inv * bflo(zw.x), O[u][mt][1] * inv * bfhi(zw.x)); o.y = pk2(O[u][mt][2] * inv * bflo(zw.y), O[u][mt][3] * inv * bfhi(zw.y));
            *(u32x2*)(p.AB + tok * DM + 1024 + h * 128 + d0) = o; }
    }
}

__device__ __forceinline__ bf16x8 gather_kn(const bf16_t* base, int ld, int k0, int n) {
    union { bf16x8 v; bf16_t s[8]; } u;
#pragma unroll
    for (int j = 0; j < 8; ++j) u.s[j] = base[(k0 + j) * ld + n];
    return u.v;
}
struct CPRegs { u32x4 xw[3][2][4]; float g_in, b_in; };
__device__ __forceinline__ void cp_issue(const Params& p, int task, int tid, CPRegs& R) {
    const int bh = task >> 5, ch = task & 31, b = bh >> 3, h = bh & 7, sch0 = ch * 64;
    const size_t token0 = (size_t)b * SEQ + ch * 64;
#pragma unroll
    for (int mat = 0; mat < 3; ++mat)
#pragma unroll
        for (int i = 0; i < 2; ++i) { const int row = (tid + i * NTHR) >> 4;
#pragma unroll
            for (int j = 0; j < 4; ++j) { const bool ok = (sch0 + row - 3 + j >= 0); const size_t tr = ok ? (token0 + row + j) - 3 : token0;
                R.xw[mat][i][j] = *(const u32x4*)(p.PROJ + tr * NPROJ + mat * 1024 + h * 128 + (tid & 15) * 8); if (!ok) R.xw[mat][i][j] = (u32x4){0u, 0u, 0u, 0u}; } }
    R.g_in = 0.f; R.b_in = 0.f;
    if (tid < 64) { R.g_in = p.G[(size_t)bh * SEQ + ch * 64 + tid]; R.b_in = p.BETA[(size_t)bh * SEQ + ch * 64 + tid]; }
}
__device__ __forceinline__ void gdn_chunk_prep(const Params& p, unsigned char* smem, int task, int next_task, CPRegs& R, int& cw_h) {
    int tid_o = threadIdx.x; asm volatile("" : "+v"(tid_o));
    const int tid = tid_o, wid = tid >> 6, lane = tid & 63, r16 = lane & 15, q4 = lane >> 4;
    bf16_t* Qs = (bf16_t*)smem; bf16_t* Ks = Qs + 64 * 136; bf16_t* Vs = Ks + 64 * 136; bf16_t* KBs = Vs + 64 * 136;
    float* Lm = (float*)(smem + 69632); float* Tm = Lm + 64 * 65; float* Mm = Tm + 64 * 65;
    bf16_t* Tb = (bf16_t*)(smem + 119552);
    float* gcs = (float*)(smem + 128768); float* bts = gcs + 64;
    const int bh = task >> 5, ch = task & 31, b = bh >> 3, h = bh & 7;
    float* cwl = (float*)(smem + 132096);
    if (h != cw_h) {
        lds_sync();
        if (tid < 384) { const int mat = tid >> 7, rem = tid & 127, j = rem >> 5, c4 = (rem & 31) * 4;
            *(float4*)&cwl[(mat * 4 + j) * 128 + c4] = *(const float4*)(p.conv_w + j * 3072 + mat * 1024 + h * 128 + c4); }
        cw_h = h;
    }
    const size_t cbase = ((size_t)bh * SEQ + ch * 64) * 128;
    const size_t token0 = (size_t)b * SEQ + ch * 64;
    lds_sync();
    if (tid < 64) { gcs[tid] = R.g_in; bts[tid] = R.b_in; }
    for (int i = tid; i < 64 * 72 / 2; i += NTHR) ((unsigned*)Tb)[i] = 0u;
    lds_sync();
    if (tid < 64) { float gcv = gcs[tid];
#pragma unroll
        for (int o = 1; o < 64; o <<= 1) { const float t = __shfl_up(gcv, o); if (lane >= o) gcv += t; }
        gcs[tid] = gcv; }
    lds_sync();
    const float gl = gcs[63];
    {
        const int piece = tid & 15;
#pragma unroll
        for (int mat = 0; mat < 3; ++mat) {
            const int col = mat * 1024 + h * 128 + piece * 8;
            float acc2[2][8];
#pragma unroll
            for (int i = 0; i < 2; ++i)
#pragma unroll
                for (int c = 0; c < 8; ++c) acc2[i][c] = 0.f;
#pragma unroll
            for (int j = 0; j < 4; ++j) { const float4 w0 = *(const float4*)&cwl[(mat * 4 + j) * 128 + piece * 8], w1 = *(const float4*)&cwl[(mat * 4 + j) * 128 + piece * 8 + 4];
#pragma unroll
                for (int i = 0; i < 2; ++i) { const u32x4 xv = R.xw[mat][i][j];
                    acc2[i][0] += w0.x * bflo(xv.x); acc2[i][1] += w0.y * bfhi(xv.x); acc2[i][2] += w0.z * bflo(xv.y); acc2[i][3] += w0.w * bfhi(xv.y);
                    acc2[i][4] += w1.x * bflo(xv.z); acc2[i][5] += w1.y * bfhi(xv.z); acc2[i][6] += w1.z * bflo(xv.w); acc2[i][7] += w1.w * bfhi(xv.w); } }
#pragma unroll
            for (int i = 0; i < 2; ++i) { const int idx = tid + i * NTHR, row = idx >> 4;
                float a[8];
#pragma unroll
                for (int c = 0; c < 8; ++c) a[c] = acc2[i][c];
                float ss = 0.f;
#pragma unroll
                for (int c = 0; c < 8; ++c) { a[c] = a[c] * __builtin_amdgcn_rcpf(1.0f + __expf(-a[c])); ss += a[c] * a[c]; }
                const float eg = __expf(gcs[row]), bt = bts[row];
                if (mat < 2) { ss += __shfl_xor(ss, 1); ss += __shfl_xor(ss, 2); ss += __shfl_xor(ss, 4); ss += __shfl_xor(ss, 8);
                    float sc = rsqrtf(ss + 1e-6f); if (mat == 0) sc *= 0.08838834764831845f;
#pragma unroll
                    for (int c = 0; c < 8; ++c) a[c] *= sc; }
                u32x4 o;
                if (mat == 0) {
                    o.x = cvt_pk_bf16(a[0], a[1]); o.y = cvt_pk_bf16(a[2], a[3]); o.z = cvt_pk_bf16(a[4], a[5]); o.w = cvt_pk_bf16(a[6], a[7]);
                    *(u32x4*)(Qs + row * 136 + piece * 8) = o;
                    o.x = cvt_pk_bf16(a[0] * eg, a[1] * eg); o.y = cvt_pk_bf16(a[2] * eg, a[3] * eg); o.z = cvt_pk_bf16(a[4] * eg, a[5] * eg); o.w = cvt_pk_bf16(a[6] * eg, a[7] * eg);
                    *(u32x4*)(p.GQ + cbase + (size_t)idx * 8) = o;
                } else if (mat == 1) {
                    o.x = cvt_pk_bf16(a[0], a[1]); o.y = cvt_pk_bf16(a[2], a[3]); o.z = cvt_pk_bf16(a[4], a[5]); o.w = cvt_pk_bf16(a[6], a[7]);
                    *(u32x4*)(Ks + row * 136 + piece * 8) = o;
                    const float kb = bt * eg;
                    o.x = cvt_pk_bf16(a[0] * kb, a[1] * kb); o.y = cvt_pk_bf16(a[2] * kb, a[3] * kb); o.z = cvt_pk_bf16(a[4] * kb, a[5] * kb); o.w = cvt_pk_bf16(a[6] * kb, a[7] * kb);
                    *(u32x4*)(KBs + row * 136 + piece * 8) = o;
                } else {
                    o.x = cvt_pk_bf16(a[0] * bt, a[1] * bt); o.y = cvt_pk_bf16(a[2] * bt, a[3] * bt); o.z = cvt_pk_bf16(a[4] * bt, a[5] * bt); o.w = cvt_pk_bf16(a[6] * bt, a[7] * bt);
                    *(u32x4*)(Vs + row * 136 + piece * 8) = o;
                }
            }
        }
    }
    if (next_task >= 0) cp_issue(p, next_task, tid, R);
    lds_sync();
    {
        const int mat = wid >> 2, ti = wid & 3;
        const bf16_t* As = mat ? Qs : Ks;
        bf16x8 af[4];
#pragma unroll
        for (int ks = 0; ks < 4; ++ks) af[ks] = *(const bf16x8*)(As + (ti * 16 + r16) * 136 + ks * 32 + q4 * 8);
#pragma unroll
        for (int tj = 0; tj < 4; ++tj) {
            f32x4 acc = (f32x4){0.f, 0.f, 0.f, 0.f};
            if (tj <= ti) {
#pragma unroll
                for (int ks = 0; ks < 4; ++ks) { const bf16x8 bfr = *(const bf16x8*)(Ks + (tj * 16 + r16) * 136 + ks * 32 + q4 * 8);
                    acc = __builtin_amdgcn_mfma_f32_16x16x32_bf16(af[ks], bfr, acc, 0, 0, 0); } }
            const int jj = tj * 16 + r16; const float gj = gcs[jj];
#pragma unroll
            for (int j = 0; j < 4; ++j) { const int i = ti * 16 + q4 * 4 + j;
                if (mat == 0) { const float v = (jj < i) ? bts[i] * acc[j] * __expf(gcs[i] - gj) : 0.f; Lm[i * 65 + jj] = v; }
                else { const float v = (jj <= i) ? acc[j] * __expf(gcs[i] - gj) : 0.f; p.AB[(token0 + i) * DM + h * 64 + jj] = f2bf(v); } }
        }
    }
    lds_sync();
    if (tid < 64) { const int blk = tid >> 4, c = tid & 15; float t[16];
#pragma unroll
        for (int i = 0; i < 16; ++i) { float a = (i == c) ? 1.f : 0.f;
#pragma unroll
            for (int j = 0; j < 16; ++j) if (j < i) a -= Lm[(blk * 16 + i) * 65 + blk * 16 + j] * t[j];
            t[i] = a; Tm[(blk * 16 + i) * 65 + blk * 16 + c] = a; } }
    lds_sync();
#pragma unroll
    for (int d = 1; d < 4; ++d) {
        if (wid < 4 - d) { const int bj = wid, bi = bj + d;
            f32x4 am = (f32x4){0.f, 0.f, 0.f, 0.f};
#pragma unroll
            for (int kk = 0; kk < 4 * d; ++kk) { const float av = Lm[(bi * 16 + r16) * 65 + bj * 16 + kk * 4 + q4]; const float bv = Tm[(bj * 16 + kk * 4 + q4) * 65 + bj * 16 + r16];
                am = __builtin_amdgcn_mfma_f32_16x16x4f32(av, bv, am, 0, 0, 0); }
#pragma unroll
            for (int j = 0; j < 4; ++j) Mm[(bi * 16 + q4 * 4 + j) * 65 + bj * 16 + r16] = am[j];
            asm volatile("s_waitcnt lgkmcnt(0)" ::: "memory");
            f32x4 at = (f32x4){0.f, 0.f, 0.f, 0.f};
#pragma unroll
            for (int kk = 0; kk < 4; ++kk) { const float av = Tm[(bi * 16 + r16) * 65 + bi * 16 + kk * 4 + q4]; const float bv = Mm[(bi * 16 + kk * 4 + q4) * 65 + bj * 16 + r16];
                at = __builtin_amdgcn_mfma_f32_16x16x4f32(av, bv, at, 0, 0, 0); }
#pragma unroll
            for (int j = 0; j < 4; ++j) Tm[(bi * 16 + q4 * 4 + j) * 65 + bj * 16 + r16] = -at[j];
        }
        lds_sync();
    }
    for (int idx = tid; idx < 4096; idx += NTHR) { const int i = idx >> 6, j = idx & 63; if ((j >> 4) <= (i >> 4)) Tb[i * 72 + j] = f2bf(Tm[i * 65 + j]); }
    lds_sync();
    {
        const int tn = wid;
        bf16x8 bu[2], bw[2];
#pragma unroll
        for (int ks = 0; ks < 2; ++ks) { bu[ks] = gather_kn(Vs, 136, ks * 32 + q4 * 8, tn * 16 + r16); bw[ks] = gather_kn(KBs, 136, ks * 32 + q4 * 8, tn * 16 + r16); }
#pragma unroll
        for (int ti = 0; ti < 4; ++ti) {
            f32x4 au = (f32x4){0.f, 0.f, 0.f, 0.f}, aw = (f32x4){0.f, 0.f, 0.f, 0.f};
#pragma unroll
            for (int ks = 0; ks < 2; ++ks) if (ks * 2 <= ti) { const bf16x8 a = *(const bf16x8*)(Tb + (ti * 16 + r16) * 72 + ks * 32 + q4 * 8);
                au = __builtin_amdgcn_mfma_f32_16x16x32_bf16(a, bu[ks], au, 0, 0, 0); aw = __builtin_amdgcn_mfma_f32_16x16x32_bf16(a, bw[ks], aw, 0, 0, 0); }
            u32x2 o; o.x = cvt_pk_bf16(au[0], au[1]); o.y = cvt_pk_bf16(au[2], au[3]);
            *(u32x2*)(p.GV + cbase + (size_t)(tn * 16 + r16) * 64 + ti * 16 + q4 * 4) = o;
#pragma unroll
            for (int j = 0; j < 4; ++j) p.WN[((size_t)task * 64 + ti * 16 + q4 * 4 + j) * 128 + tn * 16 + r16] = f2bf(-aw[j]);
        }
    }
    { const int d = tid >> 2, cg = (tid & 3) * 16; unsigned w[8];
#pragma unroll
        for (int c2 = 0; c2 < 8; ++c2) { const int c = cg + c2 * 2;
            w[c2] = cvt_pk_bf16(bf2f(Ks[c * 136 + d]) * __expf(gl - gcs[c]), bf2f(Ks[(c + 1) * 136 + d]) * __expf(gl - gcs[c + 1])); }
        u32x4 o0, o1; o0.x = w[0]; o0.y = w[1]; o0.z = w[2]; o0.w = w[3]; o1.x = w[4]; o1.y = w[5]; o1.z = w[6]; o1.w = w[7];
        *(u32x4*)(p.GK + cbase + (size_t)d * 64 + cg) = o0; *(u32x4*)(p.GK + cbase + (size_t)d * 64 + cg + 8) = o1; }
    if (tid == 0) p.GL[task] = __expf(gl);
}

__device__ __forceinline__ void gdn_scan(const Params& p, unsigned char* smem, int item) {
    int tid_o = threadIdx.x; asm volatile("" : "+v"(tid_o));
    const int tid = tid_o, wid = tid >> 6, lane = tid & 63, r16 = lane & 15, q4 = lane >> 4;
    const int bh = item >> 2, es = item & 3, b = bh >> 3, h = bh & 7;
    constexpr int SETSZ = 64 * 136 * 2 + 128 * 72 + 64 * 72 + 32 * 136 + 32 * 72;
    const int ci = wid >> 1, et = wid & 1;
    f32x4 Sacc[2]; Sacc[0] = (f32x4){0.f, 0.f, 0.f, 0.f}; Sacc[1] = (f32x4){0.f, 0.f, 0.f, 0.f};
    struct ScanRegs { u32x4 rw[2], rq[2], rk[2], ri; u32x2 ru; float rgl; };
    const int irow = tid >> 3, ipiece = tid & 7;
    auto issue = [&](int n, ScanRegs& R) {
        const int task_ = bh * 32 + n; const size_t cb_ = ((size_t)bh * SEQ + (size_t)n * 64) * 128;
#pragma unroll
        for (int i_ = 0; i_ < 2; ++i_) { const size_t o_ = (size_t)(tid + i_ * NTHR) * 8;
            R.rw[i_] = *(const u32x4*)(p.WN + (size_t)task_ * 8192 + o_); R.rq[i_] = *(const u32x4*)(p.GQ + cb_ + o_); R.rk[i_] = *(const u32x4*)(p.GK + cb_ + o_); }
        R.ri = *(const u32x4*)(p.AB + ((size_t)b * SEQ + (size_t)n * 64 + irow) * DM + h * 64 + ipiece * 8);
        R.ru = *(const u32x2*)(p.GV + cb_ + (size_t)(es * 32 + et * 16 + r16) * 64 + ci * 16 + q4 * 4);
        R.rgl = p.GL[task_];
    };
    auto body = [&](int n, ScanRegs& R) {
        bf16_t* Ws = (bf16_t*)smem + (n & 1) * SETSZ; bf16_t* QGs = Ws + 64 * 136; bf16_t* KDs = QGs + 64 * 136; bf16_t* INs = KDs + 128 * 72; bf16_t* STs = INs + 64 * 72; bf16_t* VNs = STs + 32 * 136;
#pragma unroll
        for (int i = 0; i < 2; ++i) { const int idx = tid + i * NTHR;
            *(u32x4*)(Ws + (idx >> 4) * 136 + (idx & 15) * 8) = R.rw[i]; *(u32x4*)(QGs + (idx >> 4) * 136 + (idx & 15) * 8) = R.rq[i];
            *(u32x4*)(KDs + (idx >> 3) * 72 + (idx & 7) * 8) = R.rk[i]; }
        *(u32x4*)(INs + irow * 72 + ipiece * 8) = R.ri;
#pragma unroll
        for (int e2 = 0; e2 < 2; ++e2) { u32x2 o; o.x = pk2(Sacc[e2][0], Sacc[e2][1]); o.y = pk2(Sacc[e2][2], Sacc[e2][3]);
            *(u32x2*)(STs + (e2 * 16 + r16) * 136 + wid * 16 + q4 * 4) = o; }
        const u32x2 ucur = R.ru; const float glc = R.rgl;
        lds_sync();
        if (n + 2 < 32) issue(n + 2, R);
        f32x4 vn; vn[0] = bflo(ucur.x); vn[1] = bfhi(ucur.x); vn[2] = bflo(ucur.y); vn[3] = bfhi(ucur.y);
#pragma unroll
        for (int ks = 0; ks < 4; ++ks) { const bf16x8 a = *(const bf16x8*)(Ws + (ci * 16 + r16) * 136 + ks * 32 + q4 * 8); const bf16x8 bb = *(const bf16x8*)(STs + (et * 16 + r16) * 136 + ks * 32 + q4 * 8);
            vn = __builtin_amdgcn_mfma_f32_16x16x32_bf16(a, bb, vn, 0, 0, 0); }
        { u32x2 o; o.x = pk2(vn[0], vn[1]); o.y = pk2(vn[2], vn[3]); *(u32x2*)(VNs + (et * 16 + r16) * 72 + ci * 16 + q4 * 4) = o; }
        lds_sync();
        f32x4 oo = (f32x4){0.f, 0.f, 0.f, 0.f};
#pragma unroll
        for (int ks = 0; ks < 4; ++ks) { const bf16x8 a = *(const bf16x8*)(STs + (et * 16 + r16) * 136 + ks * 32 + q4 * 8); const bf16x8 bb = *(const bf16x8*)(QGs + (ci * 16 + r16) * 136 + ks * 32 + q4 * 8);
            oo = __builtin_amdgcn_mfma_f32_16x16x32_bf16(a, bb, oo, 0, 0, 0); }
#pragma unroll
        for (int ks = 0; ks < 2; ++ks) { const bf16x8 a = *(const bf16x8*)(VNs + (et * 16 + r16) * 72 + ks * 32 + q4 * 8); const bf16x8 bb = *(const bf16x8*)(INs + (ci * 16 + r16) * 72 + ks * 32 + q4 * 8);
            oo = __builtin_amdgcn_mfma_f32_16x16x32_bf16(a, bb, oo, 0, 0, 0); }
        { u32x2 o; o.x = pk2(oo[0], oo[1]); o.y = pk2(oo[2], oo[3]);
            __hip_atomic_store((unsigned long long*)(p.ORAW + ((size_t)b * SEQ + (size_t)n * 64 + ci * 16 + r16) * 1024 + h * 128 + es * 32 + et * 16 + q4 * 4), ((unsigned long long)o.y << 32) | (unsigned long long)o.x, __ATOMIC_RELAXED, __HIP_MEMORY_SCOPE_AGENT); }
#pragma unroll
        for (int e2 = 0; e2 < 2; ++e2) { Sacc[e2][0] *= glc; Sacc[e2][1] *= glc; Sacc[e2][2] *= glc; Sacc[e2][3] *= glc;
#pragma unroll
            for (int ks = 0; ks < 2; ++ks) { const bf16x8 a = *(const bf16x8*)(KDs + (wid * 16 + r16) * 72 + ks * 32 + q4 * 8); const bf16x8 bb = *(const bf16x8*)(VNs + (e2 * 16 + r16) * 72 + ks * 32 + q4 * 8);
                Sacc[e2] = __builtin_amdgcn_mfma_f32_16x16x32_bf16(a, bb, Sacc[e2], 0, 0, 0); } }
    };
    ScanRegs r0, r1;
    issue(0, r0); issue(1, r1);
#pragma unroll 1
    for (int n = 0; n < 32; n += 2) { body(n, r0); body(n + 1, r1); }
}

__device__ __forceinline__ void phase_mix(const Params& p, unsigned char* smem) {
    { CPRegs R; int cw_h = -1; int t = blockIdx.x; if (t < 2048) cp_issue(p, t, threadIdx.x, R);
#pragma unroll 1
      for (; t < 2048; t += gridDim.x) { const int nt = t + (int)gridDim.x; gdn_chunk_prep(p, smem, t, nt < 2048 ? nt : -1, R, cw_h); } }
}
__device__ __forceinline__ void oanorm_part(const Params& p, int bh, int es);
__device__ __forceinline__ void phase_scan(const Params& p, unsigned char* smem) {
    const int wq = blockIdx.x >> 3, bh = (blockIdx.x & 7) * 8 + (wq >> 2), sub = wq & 3;
#pragma unroll 1
    for (int rep = 0; rep < SCAN_REPEAT; ++rep) gdn_scan(p, smem, bh * 4 + sub);
    flag_arrive(p.BAR + 64 + bh * 64);
#pragma unroll 1
    for (int rep = 0; rep < MOBA_REPEAT; ++rep) { moba_task(p, smem, bh, 7 - sub); moba_task(p, smem, bh, sub); }
    { const int hh = bh & 7, b8 = bh & ~7; const int h1 = hh < 4 ? 2 * hh : hh, h2 = hh < 4 ? 2 * hh + 1 : hh;
      flag_wait3(p.BAR + 64 + bh * 64, p.BAR + 64 + (b8 + h1) * 64, p.BAR + 64 + (b8 + h2) * 64, 4); }
    oanorm_part(p, bh, sub);
}

__device__ __forceinline__ void oanorm_part(const Params& p, int bh, int es) {
    const int wid = threadIdx.x >> 6, lane = threadIdx.x & 63;
    const int b = bh >> 3, h = bh & 7;
    const int cl = (lane & 7) * 16, c0 = h * 128 + cl;
    float nw[16];
#pragma unroll
    for (int i = 0; i < 4; ++i) { const float4 w = *(const float4*)(p.gdn_nw + cl + i * 4); nw[i * 4] = w.x; nw[i * 4 + 1] = w.y; nw[i * 4 + 2] = w.z; nw[i * 4 + 3] = w.w; }
#pragma unroll 2
    for (int itr = 0; itr < 8; ++itr) {
        const size_t tok = (size_t)b * SEQ + es * 512 + itr * 64 + wid * 8 + (lane >> 3);
        const u32x4 o0 = *(const u32x4*)(p.ORAW + tok * 1024 + c0), o1 = *(const u32x4*)(p.ORAW + tok * 1024 + c0 + 8);
        const u32x4 z0 = *(const u32x4*)(p.PROJ + tok * NPROJ + 3072 + c0), z1 = *(const u32x4*)(p.PROJ + tok * NPROJ + 3072 + c0 + 8);
        float o[16] = {bflo(o0.x), bfhi(o0.x), bflo(o0.y), bfhi(o0.y), bflo(o0.z), bfhi(o0.z), bflo(o0.w), bfhi(o0.w), bflo(o1.x), bfhi(o1.x), bflo(o1.y), bfhi(o1.y), bflo(o1.z), bfhi(o1.z), bflo(o1.w), bfhi(o1.w)};
        const float z[16] = {bflo(z0.x), bfhi(z0.x), bflo(z0.y), bfhi(z0.y), bflo(z0.z), bfhi(z0.z), bflo(z0.w), bfhi(z0.w), bflo(z1.x), bfhi(z1.x), bflo(z1.y), bfhi(z1.y), bflo(z1.z), bfhi(z1.z), bflo(z1.w), bfhi(z1.w)};
        float ss = 0.f;
#pragma unroll
        for (int i = 0; i < 16; ++i) ss += o[i] * o[i];
        ss += __shfl_xor(ss, 1); ss += __shfl_xor(ss, 2); ss += __shfl_xor(ss, 4);
        const float r = rsqrtf(ss * (1.0f / 128.0f) + 1e-6f);
#pragma unroll
        for (int i = 0; i < 16; ++i) o[i] = o[i] * r * nw[i] * z[i];
        u32x4 w0, w1; w0.x = pk2(o[0], o[1]); w0.y = pk2(o[2], o[3]); w0.z = pk2(o[4], o[5]); w0.w = pk2(o[6], o[7]); w1.x = pk2(o[8], o[9]); w1.y = pk2(o[10], o[11]); w1.z = pk2(o[12], o[13]); w1.w = pk2(o[14], o[15]);
        *(u32x4*)(p.AB + tok * DM + c0) = w0; *(u32x4*)(p.AB + tok * DM + c0 + 8) = w1;
    }
}

__device__ __forceinline__ void phase_final(const Params& p) {
    const int wid = threadIdx.x >> 6, lane = threadIdx.x & 63;
    for (int row = blockIdx.x * 8 + wid; row < MTOK; row += gridDim.x * 8) {
        float ss = (lane < 32) ? p.RSS[(size_t)row * 32 + lane] : 0.f;
        ss = wave_sum(ss);
        const float rs = rsqrtf(ss * (1.0f / 2048.0f) + 1e-6f);
#pragma unroll
        for (int i = 0; i < 8; ++i) { const int c = i * 256 + lane * 4;
            const float4 xv = *(const float4*)(p.x + (size_t)row * DM + c); const float4 w = *(const float4*)(p.post_w + c);
            const u32x2 yw = *(const u32x2*)(p.Y + (size_t)row * DM + c);
            float4 o; o.x = xv.x + bflo(yw.x) * rs * w.x; o.y = xv.y + bfhi(yw.x) * rs * w.y; o.z = xv.z + bflo(yw.y) * rs * w.z; o.w = xv.w + bfhi(yw.y) * rs * w.w;
            *(float4*)(p.out + (size_t)row * DM + c) = o; }
    }
}

template <int PH> __device__ __forceinline__ void run_phase(const Params& p, unsigned char* smem) {
    if (PH == 0) phase_prep(p, smem);
    else if (PH == 1) { gm::Order S; S.init(MTOK, N1, gridDim.x, blockIdx.x, 0, WGM_G1); gm::EpiProj E{p.PROJ, p.GR, p.GB, p.KMEAN}; gm::gemm_phase(( LAS unsigned char*)smem, p.H, p.WinT, 32, S, E); }
    else if (PH == 2) phase_mix(p, smem);
    else if (PH == 3) phase_scan(p, smem);
    else if (PH == 4) { gm::Order S; S.init(MTOK, DM, gridDim.x, blockIdx.x, 1, WGM_G2); gm::EpiMerge E{p.GR, p.GB, p.MERGED}; gm::gemm_phase((LAS unsigned char*)smem, p.AB, p.WabT, 16, S, E); }
    else if (PH == 5) { gm::Order S; S.init(MTOK, DM, gridDim.x, blockIdx.x, 0, WGM_G3); gm::EpiY E{p.Y, p.RSS}; gm::gemm_phase((LAS unsigned char*)smem, p.MERGED, p.WoT, 32, S, E); }
    else phase_final(p);
}

#if ONE_LAUNCH
__global__ void __launch_bounds__(NTHR, 2) fwd_mega(Params p) {
    extern __shared__ __attribute__((aligned(16))) unsigned char smem[];
    cg::grid_group grid = cg::this_grid();
#define RUNP(k) do { run_phase<k>(p, smem); if ((REPEAT_MASK >> k) & 1) { grid.sync(); run_phase<k>(p, smem); } } while (0)
    if (p.BAR == nullptr) grid.sync();
    volatile LAS unsigned* xst = (volatile LAS unsigned*)((LAS unsigned char*)smem + LDS_BYTES);
    if (threadIdx.x == 0) { xst[0] = 0u; xst[1] = 0u; xst[2] = 0u; xst[3] = 0u; }
    __syncthreads();
    const XcdBarrier xb = xcd_barrier_post(p.BAR + 8192, xst);
    RUNP(0); xcd_barrier(xb);
    RUNP(1); xcd_barrier(xb);
    RUNP(2); xcd_barrier(xb);
    RUNP(3); xcd_barrier(xb);
    RUNP(4); xcd_barrier(xb);
    RUNP(5); xcd_barrier(xb);
    run_phase<6>(p, smem);
}
#else
template <int PH> __global__ void __launch_bounds__(NTHR, 2) k_phase(Params p) {
    extern __shared__ __attribute__((aligned(16))) unsigned char smem[];
    run_phase<PH>(p, smem);
}
#endif

extern "C" void kernel_launch(void* const* d_in, const int* in_sizes, int n_in, void* d_out, int out_size, void* d_ws, size_t ws_size, hipStream_t stream) {
    if (ws_size < 500 * MiB) { fprintf(stderr, "kernel_launch: workspace too small (%zu); this kernel's workspace map ends at 500 MiB\n", ws_size); return; }
    Params p{};
    p.x = (const float*)d_in[0]; p.pre_w = (const float*)d_in[1]; p.w_in = (const float*)d_in[2]; p.conv_w = (const float*)d_in[3];
    p.a_log = (const float*)d_in[4]; p.dt_bias = (const float*)d_in[5]; p.gdn_nw = (const float*)d_in[6]; p.w_a = (const float*)d_in[7];
    p.w_b = (const float*)d_in[8]; p.w_out = (const float*)d_in[9]; p.post_w = (const float*)d_in[10];
    p.out = (float*)d_out;
    unsigned char* ws = (unsigned char*)d_ws; unsigned char* ob = (unsigned char*)d_out;
    p.PROJ = (bf16_t*)(ws); p.Y = (bf16_t*)(ws); p.GR = (bf16_t*)(ws + 256 * MiB); p.GB = (bf16_t*)(ws + 320 * MiB);
    p.WabT = (bf16_t*)(ws + 384 * MiB); p.WoT = (bf16_t*)(ws + 392 * MiB);
    p.BETA = (float*)(ws + 400 * MiB); p.G = (float*)(ws + 400 * MiB + MiB / 2); p.KMEAN = (float*)(ws + 401 * MiB); p.GL = (float*)(ws + 401 * MiB + MiB / 2); p.BAR = (unsigned*)(ws + 401 * MiB + 3 * MiB / 4); p.WN = (bf16_t*)(ws + 468 * MiB); p.RSS = (float*)(ws + 402 * MiB);
    p.WinT = (bf16_t*)(ws + 404 * MiB); p.AB = (bf16_t*)(ws + 404 * MiB);
    p.H = (bf16_t*)(ob); p.GQ = (bf16_t*)(ob); p.GK = (bf16_t*)(ob + 32 * MiB); p.GV = (bf16_t*)(ob + 64 * MiB); p.ORAW = (bf16_t*)(ob + 96 * MiB);
    p.MERGED = (bf16_t*)(ob);
#if ONE_LAUNCH
    static int grid_blocks = 0;
    if (!grid_blocks) {
        int dev = 0, cus = 0, per_cu = 0;
        hipGetDevice(&dev); hipDeviceGetAttribute(&cus, hipDeviceAttributeMultiprocessorCount, dev);
        hipFuncSetAttribute((const void*)fwd_mega, hipFuncAttributeMaxDynamicSharedMemorySize, LDS_BYTES + 16);
        hipOccupancyMaxActiveBlocksPerMultiprocessor(&per_cu, (const void*)fwd_mega, NTHR, LDS_BYTES + 16);
        if (per_cu < 1) per_cu = 1;
        grid_blocks = cus * per_cu;
        if (grid_blocks > 256) grid_blocks = 256;
    }
    (void)hipMemsetAsync(p.BAR, 0, (8192 + XCD_BAR_WORDS) * 4, stream);
    void* args[] = {&p};
    hipError_t e = hipLaunchCooperativeKernel((const void*)fwd_mega, dim3(grid_blocks), dim3(NTHR), args, LDS_BYTES + 16, stream);
    if (e != hipSuccess) fprintf(stderr, "cooperative launch failed: %s (grid %d)\n", hipGetErrorString(e), grid_blocks);
#else
    static int inited = 0;
    if (!inited) { inited = 1;
        hipFuncSetAttribute((const void*)k_phase<0>, hipFuncAttributeMaxDynamicSharedMemorySize, LDS_BYTES);
        hipFuncSetAttribute((const void*)k_phase<1>, hipFuncAttributeMaxDynamicSharedMemorySize, LDS_BYTES);
        hipFuncSetAttribute((const void*)k_phase<2>, hipFuncAttributeMaxDynamicSharedMemorySize, LDS_BYTES);
        hipFuncSetAttribute((const void*)k_phase<3>, hipFuncAttributeMaxDynamicSharedMemorySize, LDS_BYTES);
        hipFuncSetAttribute((const void*)k_phase<4>, hipFuncAttributeMaxDynamicSharedMemorySize, LDS_BYTES);
        hipFuncSetAttribute((const void*)k_phase<5>, hipFuncAttributeMaxDynamicSharedMemorySize, LDS_BYTES);
        hipFuncSetAttribute((const void*)k_phase<6>, hipFuncAttributeMaxDynamicSharedMemorySize, LDS_BYTES);
        hipFuncSetAttribute((const void*)k_phase<7>, hipFuncAttributeMaxDynamicSharedMemorySize, LDS_BYTES);
    }
    const int G = 256;
#define LP(k) do { k_phase<k><<<G, NTHR, LDS_BYTES, stream>>>(p); if ((REPEAT_MASK >> k) & 1) k_phase<k><<<G, NTHR, LDS_BYTES, stream>>>(p); } while (0)
    LP(0); LP(1); LP(2); LP(3); LP(4); LP(5); LP(6);
#endif
}
```

```cpp
#include <hip/hip_runtime.h>
#include <hip/hip_cooperative_groups.h>
#include <cstdio>
#include <cstdint>
namespace cg = cooperative_groups;

#ifndef ONE_LAUNCH
#define ONE_LAUNCH 1
#endif

#ifndef CP_REPEAT
#define CP_REPEAT 1
#endif
#ifndef SCAN_REPEAT
#define SCAN_REPEAT 1
#endif
#ifndef MOBA_REPEAT
#define MOBA_REPEAT 1
#endif
#ifndef WGM_G1
#define WGM_G1 4
#endif
#ifndef WGM_G2
#define WGM_G2 4
#endif
#ifndef WGM_G3
#define WGM_G3 4
#endif
#ifndef REPEAT_MASK
#define REPEAT_MASK 0
#endif
#define LAS __attribute__((address_space(3)))
typedef unsigned short bf16_t;
typedef short bf16x8 __attribute__((ext_vector_type(8)));
typedef float f32x4 __attribute__((ext_vector_type(4)));
typedef unsigned u32x4 __attribute__((ext_vector_type(4)));
typedef unsigned u32x2 __attribute__((ext_vector_type(2)));

constexpr int NTHR = 512;
constexpr int LDS_BYTES = 155648;
constexpr int SEQ = 2048, DM = 2048, MTOK = 16384, NPROJ = 8192, N1 = 12288, INW = 12304;
constexpr size_t MiB = 1u << 20;

struct Params {
    const float *x, *pre_w, *w_in, *conv_w, *a_log, *dt_bias, *gdn_nw, *w_a, *w_b, *w_out, *post_w;
    float* out;
    bf16_t *H, *PROJ, *WinT, *WabT, *WoT, *GQ, *GK, *GV, *ORAW, *AB, *MERGED, *Y;
    float *BETA, *G, *KMEAN, *RSS, *GL;
    bf16_t* WN;
    unsigned* BAR;
    bf16_t *GR, *GB;
};

__device__ __forceinline__ float bf2f(bf16_t v) { return __uint_as_float(((unsigned)v) << 16); }
__device__ __forceinline__ float bflo(unsigned w) { return __uint_as_float(w << 16); }
__device__ __forceinline__ float bfhi(unsigned w) { return __uint_as_float(w & 0xffff0000u); }
typedef __bf16 hwbf16x2 __attribute__((ext_vector_type(2)));
typedef float f32x2v __attribute__((ext_vector_type(2)));
__device__ __forceinline__ unsigned cvt_pk_bf16(float lo, float hi) { f32x2v v = {lo, hi}; hwbf16x2 b = __builtin_convertvector(v, hwbf16x2); return __builtin_bit_cast(unsigned, b); }
__device__ __forceinline__ unsigned pk2(float lo, float hi) { return cvt_pk_bf16(lo, hi); }
__device__ __forceinline__ bf16_t f2bf(float f) { return (bf16_t)(cvt_pk_bf16(f, 0.f) & 0xffffu); }
__device__ __forceinline__ float sigmoidf_(float v) { return __builtin_amdgcn_rcpf(1.0f + __expf(-v)); }
__device__ __forceinline__ float siluf_(float v) { return v * sigmoidf_(v); }
__device__ __forceinline__ void lds_sync() { asm volatile("s_waitcnt lgkmcnt(0)" ::: "memory"); __builtin_amdgcn_s_barrier(); asm volatile("" ::: "memory"); }
#define XB_TMO      128
#define XB_XCNT(j)  (256  + 64 * (j))
#define XB_XSUB(j)  (1280 + 64 * (j))
#define XB_XGEN(j)  (2304 + 64 * (j))
#define XB_TOP      3328
#define XB_TOPGEN   3392
#define XCD_BAR_WORDS 3456
#define XB_SPIN_CAP (1u << 20)
__device__ __forceinline__ unsigned xb_ld(unsigned* p)              { return __hip_atomic_load(p, __ATOMIC_RELAXED, __HIP_MEMORY_SCOPE_AGENT); }
__device__ __forceinline__ unsigned xb_add(unsigned* p, unsigned v) { return __hip_atomic_fetch_add(p, v, __ATOMIC_RELAXED, __HIP_MEMORY_SCOPE_AGENT); }
__device__ __forceinline__ unsigned xb_xcc_id() { return (unsigned)__builtin_amdgcn_s_getreg((3 << 11) | 20) & 0xFu; }
#define XB_SPIN(cond, bar) do { unsigned _sp = 0; while (cond) { __builtin_amdgcn_s_sleep(1); \
    if ((++_sp & 255u) == 0u) { if (xb_ld(&(bar)[XB_TMO])) break; if (_sp > XB_SPIN_CAP) { atomicAdd(&(bar)[XB_TMO], 1u); break; } } } } while (0)
struct XcdBarrier { unsigned* bar; unsigned x; volatile LAS unsigned* st; };
__device__ __forceinline__ XcdBarrier xcd_barrier_post(unsigned* bar, volatile LAS unsigned* st) {
    XcdBarrier b; b.bar = bar; b.x = xb_xcc_id(); b.st = st;
    if (threadIdx.x == 0) (void)xb_add(&bar[XB_XCNT(b.x)], 1u);
    return b;
}
__device__ __forceinline__ void xcd_barrier_complete(unsigned* bar, unsigned x, unsigned& nloc, unsigned& nx) {
    const unsigned G = gridDim.x * gridDim.y * gridDim.z;
    unsigned sum, cnt, mine, sp = 0u;
    for (;;) {
        sum = 0u; cnt = 0u; mine = 0u;
#pragma unroll
        for (unsigned j = 0; j < 16; ++j) { const unsigned c = xb_ld(&bar[XB_XCNT(j)]); sum += c; cnt += (c > 0u) ? 1u : 0u; mine = (j == x) ? c : mine; }
        if (sum == G) break;
        __builtin_amdgcn_s_sleep(1);
        if ((++sp & 255u) == 0u) { if (xb_ld(&bar[XB_TMO])) break; if (sp > XB_SPIN_CAP) { atomicAdd(&bar[XB_TMO], 1u); break; } }
    }
    nloc = mine > 0u ? mine : 1u; nx = cnt > 0u ? cnt : 1u;
}
__device__ __forceinline__ void xcd_barrier(const XcdBarrier& b) {
    asm volatile("s_waitcnt vmcnt(0)" ::: "memory");
    __syncthreads();
    if (threadIdx.x == 0) {
        unsigned* bar = b.bar;
        __builtin_amdgcn_s_waitcnt(0);
        unsigned nloc = b.st[0], nx = b.st[1];
        if (nloc == 0u) { xcd_barrier_complete(bar, b.x, nloc, nx); b.st[0] = nloc; b.st[1] = nx; }
        const unsigned old = xb_add(&bar[XB_XSUB(b.x)], 1u);
        const unsigned gen = old / nloc;
        if (old + 1u == (gen + 1u) * nloc) {
            __builtin_amdgcn_fence(__ATOMIC_RELEASE, "agent");
            asm volatile("s_waitcnt vmcnt(0)" ::: "memory");
            const unsigned og = xb_add(&bar[XB_TOP], 1u);
            const unsigned tg = og / nx;
            if (og + 1u == (tg + 1u) * nx) xb_add(&bar[XB_TOPGEN], 1u);
            else XB_SPIN(xb_ld(&bar[XB_TOPGEN]) == tg, bar);
            __builtin_amdgcn_fence(__ATOMIC_ACQUIRE, "agent");
            xb_add(&bar[XB_XGEN(b.x)], 1u);
            asm volatile("s_waitcnt vmcnt(0)" ::: "memory");
        } else {
            XB_SPIN(xb_ld(&bar[XB_XGEN(b.x)]) == gen, bar);
            __builtin_amdgcn_fence(__ATOMIC_ACQUIRE, "agent");
            asm volatile("s_waitcnt vmcnt(0)" ::: "memory");
        }
    }
    __syncthreads();
}
__device__ __forceinline__ void grid_barrier(unsigned* ctr, unsigned target) {
    asm volatile("s_waitcnt vmcnt(0)" ::: "memory");
    __syncthreads();
    if (threadIdx.x < 64) {
        if (threadIdx.x == 0) {
            __builtin_amdgcn_fence(__ATOMIC_RELEASE, "agent");
            asm volatile("s_waitcnt vmcnt(0)" ::: "memory");
            __hip_atomic_fetch_add(ctr, 1u, __ATOMIC_RELAXED, __HIP_MEMORY_SCOPE_AGENT);
            unsigned spins = 0;
            while (__hip_atomic_load(ctr, __ATOMIC_RELAXED, __HIP_MEMORY_SCOPE_AGENT) < target) { __builtin_amdgcn_s_sleep(2); if (++spins > (1u << 24)) break; }
        }
        __builtin_amdgcn_fence(__ATOMIC_ACQUIRE, "agent");
        asm volatile("s_waitcnt vmcnt(0)" ::: "memory");
    }
    __syncthreads();
}
__device__ __forceinline__ void flag_arrive(unsigned* ctr) {
    asm volatile("s_waitcnt vmcnt(0)" ::: "memory");
    __syncthreads();
    if (threadIdx.x == 0) __hip_atomic_fetch_add(ctr, 1u, __ATOMIC_RELAXED, __HIP_MEMORY_SCOPE_AGENT);
}
__device__ __forceinline__ void flag_wait3(unsigned* c0, unsigned* c1, unsigned* c2, unsigned target) {
    if (threadIdx.x < 64) {
        if (threadIdx.x == 0) { unsigned spins = 0;
            while (__hip_atomic_load(c0, __ATOMIC_RELAXED, __HIP_MEMORY_SCOPE_AGENT) < target || __hip_atomic_load(c1, __ATOMIC_RELAXED, __HIP_MEMORY_SCOPE_AGENT) < target ||
                   __hip_atomic_load(c2, __ATOMIC_RELAXED, __HIP_MEMORY_SCOPE_AGENT) < target) { __builtin_amdgcn_s_sleep(2); if (++spins > (1u << 24)) break; } }
        __builtin_amdgcn_fence(__ATOMIC_ACQUIRE, "agent");
        asm volatile("s_waitcnt vmcnt(0)" ::: "memory");
    }
    __syncthreads();
}
__device__ __forceinline__ float wave_sum(float v) {
#pragma unroll
    for (int o = 32; o >= 1; o >>= 1) v += __shfl_xor(v, o);
    return v;
}

namespace gm {
constexpr int BM = 256, BK = 64, HALF = 128, HTB = HALF * BK * 2, NXCD = 8, LD = 2048;
__device__ __forceinline__ int lds_byte(int r, int c) { const int st = (r >> 4) * 2 + (c >> 5), rr = r & 15, cc = c & 31, ob = rr * 64 + cc * 2; return st * 1024 + (ob ^ (((ob >> 9) & 1) << 5)); }
__device__ __forceinline__ void stage_rc(int b, int& R, int& C) { const int st = b / 1024, sb = b % 1024, swz = sb ^ (((sb >> 9) & 1) << 5); R = (st >> 1) * 16 + swz / 64; C = (st & 1) * 32 + (swz % 64) / 2; }
__device__ __forceinline__ int perm32(int rho) { const int n = rho >> 4, i = rho & 15; return 8 * (i >> 2) + 4 * n + (i & 3); }

struct Unit { int pm, pn, half; };
struct Order {
    int nM, nN, nwg, G, c, two, WGM;
    __device__ void init(int M, int N, int G_, int c_, int two_, int wgm_) { nM = M / BM; nN = N / BM; nwg = nM * nN; G = G_; c = c_; two = two_; WGM = wgm_; }
    __device__ bool next(int i, Unit& u) const {
        const int ti = two ? (i >> 1) : i; u.half = two ? (i & 1) : 0;
        const long L = (long)ti * G + c; if (L >= nwg) return false;
        int wgid = (int)L; { const int q = nwg / NXCD, r = nwg % NXCD, xcd = wgid % NXCD, off = wgid / NXCD; wgid = (xcd < r ? xcd * (q + 1) : r * (q + 1) + (xcd - r) * q) + off; }
        const int nig = WGM * nN, gid = wgid / nig, fm = gid * WGM, gsz = (nM - fm) < WGM ? (nM - fm) : WGM;
        u.pm = fm + ((wgid % nig) % gsz); u.pn = (wgid % nig) / gsz; return true;
    }
};

template <class Epi, bool ALIGN_EPI = true, bool SP2 = true>
__device__ __forceinline__ void gemm_phase(LAS unsigned char* lds, const bf16_t* Abase, const bf16_t* Bbase, const int nt, const Order& S, const Epi& E) {
    int tid_ = threadIdx.x; asm volatile("" : "+v"(tid_));
    const int tid = tid_, wid = __builtin_amdgcn_readfirstlane(tid >> 6), lane = tid & 63, wr = wid >> 2, wc = wid & 3, fr = lane & 15, fq = lane >> 4;
    unsigned voffA[2], voffB[2];
#pragma unroll
    for (int i = 0; i < 2; ++i) { int R, C; stage_rc(tid * 16 + i * 8192, R, C); const int Rb = (R & ~31) + perm32(R & 31);
        voffA[i] = (unsigned)(R * LD + C) * 2u; voffB[i] = (unsigned)(Rb * LD + C) * 2u; }
    const size_t kstep = (size_t)(BK * 2);
    const size_t hstep = (size_t)HALF * LD * 2;
    const size_t tstep = 2 * hstep;
    const size_t halfoff = (size_t)nt * BK * 2;
    const unsigned ldsw = (unsigned)wid * 1024u;
    const int aoff = lds_byte(wr * 64 + fr, fq * 8), boff = lds_byte(wc * 32 + fr, fq * 8);
#define PG8_SA(b, h) (((b) * 2 + (h)) * HTB)
#define PG8_SB(b, h) ((4 + (b) * 2 + (h)) * HTB)
#define PG8_STAGE(bufoff, gbase, voff) do { _Pragma("unroll") for (int _i = 0; _i < 2; ++_i) \
        __builtin_amdgcn_global_load_lds((const unsigned*)((const char*)(gbase) + (voff)[_i]), (LAS unsigned*)(lds + (bufoff) + ldsw + _i * 8192), 16, 0, 0); } while (0)
#define PG8_LDA(dst, b, h) do { _Pragma("unroll") for (int m = 0; m < 4; ++m) _Pragma("unroll") for (int k = 0; k < 2; ++k) dst[m][k] = *(const LAS bf16x8*)(lds + PG8_SA(b, h) + aoff + m * 2048 + k * 1024); } while (0)
#define PG8_LDB(dst, b, h) do { _Pragma("unroll") for (int n = 0; n < 2; ++n) _Pragma("unroll") for (int k = 0; k < 2; ++k) dst[n][k] = *(const LAS bf16x8*)(lds + PG8_SB(b, h) + boff + n * 2048 + k * 1024); } while (0)
#define PG8_MMA(ai, bj, At, Bt) do { __builtin_amdgcn_s_setprio(1); _Pragma("unroll") for (int m = 0; m < 4; ++m) _Pragma("unroll") for (int n = 0; n < 2; ++n) _Pragma("unroll") for (int k = 0; k < 2; ++k) \
        acc[ai][bj][m][n] = __builtin_amdgcn_mfma_f32_16x16x32_bf16(Bt[n][k], At[m][k], acc[ai][bj][m][n], 0, 0, 0); __builtin_amdgcn_s_setprio(0); } while (0)
#define PG8_WAIT_V(n) asm volatile("s_waitcnt vmcnt(" #n ")" ::: "memory")
#define PG8_WAIT_L(n) asm volatile("s_waitcnt lgkmcnt(" #n ")" ::: "memory")
#define PG8_BAR __builtin_amdgcn_s_barrier()
#define PG8_SCHED __builtin_amdgcn_sched_barrier(0)
    Unit cur, nxt; int ui = 0;
    if (!S.next(0, cur)) return;
    f32x4 acc[2][2][4][2];
#pragma unroll
    for (int a = 0; a < 2; ++a)
#pragma unroll
        for (int b = 0; b < 2; ++b)
#pragma unroll
            for (int m = 0; m < 4; ++m)
#pragma unroll
                for (int n = 0; n < 2; ++n) acc[a][b][m][n] = (f32x4){0.f, 0.f, 0.f, 0.f};
    bf16x8 At[4][2], B0[2][2], B1[2][2];
    const char* cA = (const char*)Abase + (size_t)cur.pm * tstep + (size_t)cur.half * halfoff; const char* cB = (const char*)Bbase + (size_t)cur.pn * tstep + (size_t)cur.half * halfoff;
    if constexpr (SP2) {
        PG8_STAGE(PG8_SB(0, 0), cB, voffB); PG8_STAGE(PG8_SB(0, 1), cB + hstep, voffB); PG8_STAGE(PG8_SA(0, 0), cA, voffA); PG8_STAGE(PG8_SA(0, 1), cA + hstep, voffA);
        if (wr == 1) PG8_BAR;
        PG8_WAIT_V(2); PG8_BAR;
        PG8_STAGE(PG8_SB(1, 0), cB + kstep, voffB); PG8_STAGE(PG8_SA(1, 0), cA + kstep, voffA); PG8_STAGE(PG8_SB(1, 1), cB + hstep + kstep, voffB);
        PG8_WAIT_V(6); PG8_BAR;
    } else {
        PG8_STAGE(PG8_SB(0, 0), cB, voffB); PG8_STAGE(PG8_SA(0, 0), cA, voffA); PG8_STAGE(PG8_SB(0, 1), cB + hstep, voffB); PG8_STAGE(PG8_SA(0, 1), cA + hstep, voffA);
        if (wr == 1) PG8_BAR;
        PG8_WAIT_V(4); PG8_BAR;
        PG8_STAGE(PG8_SB(1, 0), cB + kstep, voffB); PG8_STAGE(PG8_SA(1, 0), cA + kstep, voffA); PG8_STAGE(PG8_SB(1, 1), cB + hstep + kstep, voffB);
        PG8_WAIT_V(6); PG8_BAR;
    }
    for (;;) {
        const bool has_next = S.next(ui + 1, nxt);
        const char* nA = has_next ? (const char*)Abase + (size_t)nxt.pm * tstep + (size_t)nxt.half * halfoff : cA;
        const char* nB = has_next ? (const char*)Bbase + (size_t)nxt.pn * tstep + (size_t)nxt.half * halfoff : cB;
        for (int t = 0; t < nt; t += 2) {
            const bool last = (t == nt - 2);
            const char* a1 = cA + (size_t)(t + 1) * kstep;
            const char* a2 = last ? nA : cA + (size_t)(t + 2) * kstep; const char* b2 = last ? nB : cB + (size_t)(t + 2) * kstep;
            const char* a3 = a2 + kstep; const char* b3 = b2 + kstep;
            if constexpr (SP2) {
            PG8_LDB(B0, 0, 0); PG8_LDB(B1, 0, 1); PG8_SCHED; PG8_LDA(At, 0, 0); PG8_STAGE(PG8_SA(1, 1), a1 + hstep, voffA);
            PG8_WAIT_V(8); PG8_WAIT_L(0); PG8_BAR; PG8_MMA(0, 0, At, B0); PG8_MMA(0, 1, At, B1); PG8_BAR; PG8_SCHED;
            PG8_LDA(At, 0, 1); PG8_STAGE(PG8_SB(0, 0), b2, voffB); PG8_STAGE(PG8_SB(0, 1), b2 + hstep, voffB); PG8_STAGE(PG8_SA(0, 0), a2, voffA);
            PG8_WAIT_V(8); PG8_WAIT_L(0); PG8_BAR; PG8_MMA(1, 0, At, B0); PG8_MMA(1, 1, At, B1); PG8_BAR; PG8_SCHED;
            PG8_LDB(B0, 1, 0); PG8_LDB(B1, 1, 1); PG8_SCHED; PG8_LDA(At, 1, 0); PG8_STAGE(PG8_SA(0, 1), a2 + hstep, voffA);
            PG8_WAIT_V(8); PG8_WAIT_L(0); PG8_BAR; PG8_MMA(0, 0, At, B0); PG8_MMA(0, 1, At, B1); PG8_BAR; PG8_SCHED;
            PG8_LDA(At, 1, 1); PG8_STAGE(PG8_SB(1, 0), b3, voffB); PG8_STAGE(PG8_SB(1, 1), b3 + hstep, voffB); PG8_STAGE(PG8_SA(1, 0), a3, voffA);
            PG8_WAIT_V(8); PG8_WAIT_L(0); PG8_BAR; PG8_MMA(1, 0, At, B0); PG8_MMA(1, 1, At, B1); PG8_BAR; PG8_SCHED;
            } else {
            PG8_LDB(B0, 0, 0); PG8_SCHED; PG8_LDA(At, 0, 0); PG8_STAGE(PG8_SA(1, 1), a1 + hstep, voffA);
            PG8_WAIT_L(8); PG8_BAR; PG8_WAIT_L(0); PG8_MMA(0, 0, At, B0); PG8_BAR; PG8_SCHED;
            PG8_LDB(B1, 0, 1); PG8_STAGE(PG8_SB(0, 0), b2, voffB);
            PG8_BAR; PG8_WAIT_L(0); PG8_MMA(0, 1, At, B1); PG8_BAR;
            PG8_LDA(At, 0, 1); PG8_STAGE(PG8_SA(0, 0), a2, voffA);
            PG8_BAR; PG8_WAIT_L(0); PG8_MMA(1, 0, At, B0); PG8_BAR; PG8_SCHED;
            PG8_STAGE(PG8_SB(0, 1), b2 + hstep, voffB);
            PG8_WAIT_V(6); PG8_BAR; PG8_MMA(1, 1, At, B1); PG8_BAR;
            PG8_LDB(B0, 1, 0); PG8_SCHED; PG8_LDA(At, 1, 0); PG8_STAGE(PG8_SA(0, 1), a2 + hstep, voffA);
            PG8_WAIT_L(8); PG8_BAR; PG8_WAIT_L(0); PG8_MMA(0, 0, At, B0); PG8_BAR; PG8_SCHED;
            PG8_LDB(B1, 1, 1); PG8_STAGE(PG8_SB(1, 0), b3, voffB);
            PG8_BAR; PG8_WAIT_L(0); PG8_MMA(0, 1, At, B1); PG8_BAR;
            PG8_LDA(At, 1, 1); PG8_STAGE(PG8_SA(1, 0), a3, voffA);
            PG8_BAR; PG8_WAIT_L(0); PG8_MMA(1, 0, At, B0); PG8_BAR; PG8_SCHED;
            PG8_STAGE(PG8_SB(1, 1), b3 + hstep, voffB);
            PG8_WAIT_V(6); PG8_BAR; PG8_MMA(1, 1, At, B1); PG8_BAR;
            }
        }
        if constexpr (ALIGN_EPI) { if (wr == 0) PG8_BAR; }
        E(acc, cur, wr, wc, fr, fq);
        if (!has_next) break;
        if (!E.keep(cur)) {
#pragma unroll
            for (int a = 0; a < 2; ++a)
#pragma unroll
                for (int b = 0; b < 2; ++b)
#pragma unroll
                    for (int m = 0; m < 4; ++m)
#pragma unroll
                        for (int n = 0; n < 2; ++n) acc[a][b][m][n] = (f32x4){0.f, 0.f, 0.f, 0.f};
        }
        cur = nxt; cA = nA; cB = nB; ++ui;
        if constexpr (ALIGN_EPI) { if (wr == 1) PG8_BAR; }
    }
    PG8_WAIT_V(0);
    if constexpr (!ALIGN_EPI) { if (wr == 0) PG8_BAR; }
    PG8_BAR;
#undef PG8_SA
#undef PG8_SB
#undef PG8_STAGE
#undef PG8_LDA
#undef PG8_LDB
#undef PG8_MMA
#undef PG8_WAIT_V
#undef PG8_WAIT_L
#undef PG8_BAR
#undef PG8_SCHED
}

struct EpiProj {
    bf16_t* O; bf16_t* GR; bf16_t* GB; float* KM;
    __device__ __forceinline__ bool keep(const Unit&) const { return false; }
    __device__ __forceinline__ void operator()(f32x4 (&acc)[2][2][4][2], const Unit& u, int wr, int wc, int fr, int fq) const {
        if (u.pn >= 20 && u.pn < 24) {
#pragma unroll
            for (int bj = 0; bj < 2; ++bj)
#pragma unroll
                for (int n = 0; n < 2; ++n)
#pragma unroll
                    for (int j = 0; j < 4; ++j) { float sm = 0.f;
#pragma unroll
                        for (int ai = 0; ai < 2; ++ai)
#pragma unroll
                            for (int m = 0; m < 4; ++m) sm += acc[ai][bj][m][n][j];
                        sm += __shfl_xor(sm, 1); sm += __shfl_xor(sm, 2); sm += __shfl_xor(sm, 4); sm += __shfl_xor(sm, 8);
                        if (fr == 0) { const int colr = (u.pn - 20) * 256 + bj * 128 + wc * 32 + 8 * fq + 4 * n + j;
                            atomicAdd(KM + ((size_t)((u.pm >> 3) * 8 + (colr >> 7)) * 8 + (u.pm & 7)) * 128 + (colr & 127), sm * (1.0f / 256.0f)); } }
        }
        if (u.pn >= 32) {
            const size_t tbase = ((size_t)(u.pm * 16 + (u.pn - 32)) * 8) * 512 + threadIdx.x;
#pragma unroll
            for (int ai = 0; ai < 2; ++ai)
#pragma unroll
                for (int m = 0; m < 4; ++m) { float r[8], g[8];
#pragma unroll
                    for (int n = 0; n < 2; ++n)
#pragma unroll
                        for (int j = 0; j < 4; ++j) { const float ea = __expf(fminf(-acc[ai][0][m][n][j], 80.f)), eb = __expf(fminf(-acc[ai][1][m][n][j], 80.f));
                            const float sb = __builtin_amdgcn_rcpf(1.0f + eb); g[n * 4 + j] = sb; r[n * 4 + j] = __builtin_amdgcn_rcpf(1.0f + ea) * (1.0f + eb); }
                    u32x4 wr_, wg_; wr_.x = cvt_pk_bf16(r[0], r[1]); wr_.y = cvt_pk_bf16(r[2], r[3]); wr_.z = cvt_pk_bf16(r[4], r[5]); wr_.w = cvt_pk_bf16(r[6], r[7]);
                    wg_.x = cvt_pk_bf16(g[0], g[1]); wg_.y = cvt_pk_bf16(g[2], g[3]); wg_.z = cvt_pk_bf16(g[4], g[5]); wg_.w = cvt_pk_bf16(g[6], g[7]);
                    const size_t o = (tbase + (size_t)(ai * 4 + m) * 512) * 8;
                    *(u32x4*)(GR + o) = wr_; *(u32x4*)(GB + o) = wg_; }
            return;
        }
        const int row0 = u.pm * BM + wr * 64 + fr, col0 = u.pn * BM + wc * 32 + 8 * fq;
        const int act = ((u.pn >= 12 && u.pn < 16) || (u.pn >= 28)) ? 1 : 0;
#pragma unroll
        for (int ai = 0; ai < 2; ++ai)
#pragma unroll
            for (int m = 0; m < 4; ++m) { bf16_t* rowp = O + (size_t)(row0 + ai * HALF + m * 16) * NPROJ + col0;
#pragma unroll
                for (int bj = 0; bj < 2; ++bj) { f32x4 v0 = acc[ai][bj][m][0], v1 = acc[ai][bj][m][1];
                    if (act == 1) {
#pragma unroll
                        for (int j = 0; j < 4; ++j) { v0[j] = siluf_(v0[j]); v1[j] = siluf_(v1[j]); } }
                    u32x4 w; w.x = cvt_pk_bf16(v0[0], v0[1]); w.y = cvt_pk_bf16(v0[2], v0[3]); w.z = cvt_pk_bf16(v1[0], v1[1]); w.w = cvt_pk_bf16(v1[2], v1[3]);
                    *(u32x4*)(rowp + bj * HALF) = w; } }
    }
};
struct EpiMerge {
    const bf16_t* GR; const bf16_t* GB; bf16_t* O;
    __device__ __forceinline__ bool keep(const Unit& u) const { return u.half == 0; }
    __device__ __forceinline__ void operator()(f32x4 (&acc)[2][2][4][2], const Unit& u, int wr, int wc, int fr, int fq) const {
        const int row0 = u.pm * BM + wr * 64 + fr, col0 = u.pn * BM + wc * 32 + 8 * fq;
        const bf16_t* G = (u.half == 0) ? GR : GB;
#pragma unroll
        for (int ai = 0; ai < 2; ++ai) {
            u32x4 gv[4][2];
#pragma unroll
            for (int m = 0; m < 4; ++m)
#pragma unroll
                for (int bj = 0; bj < 2; ++bj)
                    gv[m][bj] = *(const u32x4*)(G + ((((size_t)(u.pm * 16 + u.pn * 2 + bj) * 8) + ai * 4 + m) * 512 + threadIdx.x) * 8);
#pragma unroll
            for (int m = 0; m < 4; ++m)
#pragma unroll
                for (int bj = 0; bj < 2; ++bj) { const size_t row = (size_t)(row0 + ai * HALF + m * 16); const int col = col0 + bj * HALF;
                    const u32x4 gb = gv[m][bj];
                    const float fb[8] = {bflo(gb.x), bfhi(gb.x), bflo(gb.y), bfhi(gb.y), bflo(gb.z), bfhi(gb.z), bflo(gb.w), bfhi(gb.w)};
                    if (u.half == 0) {
#pragma unroll
                        for (int j = 0; j < 4; ++j) { acc[ai][bj][m][0][j] *= fb[j]; acc[ai][bj][m][1][j] *= fb[4 + j]; }
                    } else {
                        f32x4 v0 = acc[ai][bj][m][0], v1 = acc[ai][bj][m][1];
#pragma unroll
                        for (int j = 0; j < 4; ++j) { v0[j] *= fb[j]; v1[j] *= fb[4 + j]; }
                        u32x4 w; w.x = cvt_pk_bf16(v0[0], v0[1]); w.y = cvt_pk_bf16(v0[2], v0[3]); w.z = cvt_pk_bf16(v1[0], v1[1]); w.w = cvt_pk_bf16(v1[2], v1[3]);
                        *(u32x4*)(O + row * DM + col) = w;
                    } }
        }
    }
};
struct EpiY {
    bf16_t* Y; float* RSS;
    __device__ __forceinline__ bool keep(const Unit&) const { return false; }
    __device__ __forceinline__ void operator()(f32x4 (&acc)[2][2][4][2], const Unit& u, int wr, int wc, int fr, int fq) const {
        const int row0 = u.pm * BM + wr * 64 + fr, col0 = u.pn * BM + wc * 32 + 8 * fq;
#pragma unroll
        for (int ai = 0; ai < 2; ++ai)
#pragma unroll
            for (int m = 0; m < 4; ++m) { const size_t row = (size_t)(row0 + ai * HALF + m * 16); float ss = 0.f;
#pragma unroll
                for (int bj = 0; bj < 2; ++bj) { const f32x4 v0 = acc[ai][bj][m][0], v1 = acc[ai][bj][m][1];
#pragma unroll
                    for (int j = 0; j < 4; ++j) ss += v0[j] * v0[j] + v1[j] * v1[j];
                    u32x4 w; w.x = cvt_pk_bf16(v0[0], v0[1]); w.y = cvt_pk_bf16(v0[2], v0[3]); w.z = cvt_pk_bf16(v1[0], v1[1]); w.w = cvt_pk_bf16(v1[2], v1[3]);
                    *(u32x4*)(Y + row * DM + col0 + bj * HALF) = w; }
                ss += __shfl_xor(ss, 16); ss += __shfl_xor(ss, 32);
                if (fq == 0) RSS[row * 32 + u.pn * 4 + wc] = ss; }
    }
};
}

__device__ __forceinline__ void phase_prep(const Params& p, unsigned char* smem) {
    const int tid = threadIdx.x, wid = tid >> 6, lane = tid & 63;
    {
        float* T = (float*)smem;
        auto decode = [&](int t, const float*& src, bf16_t*& dst, int& ld) {
            if (t < 6144) { const int kt = t / 192, ntile = t % 192; const int n0 = ntile * 64; int sc = n0 < 4096 ? n0 : n0 + 16;
                if (n0 >= 8192) { const int rel = n0 - 8192, tl = rel >> 8, j0 = rel & 255; sc = ((j0 >> 7) ? 10256 : 8208) + tl * 128 + (j0 & 127); }
                src = p.w_in + (size_t)(kt * 64) * INW + sc; ld = INW; dst = p.WinT + (size_t)n0 * 2048 + kt * 64; }
            else if (t < 7168) { const int t2 = t - 6144, kt = t2 >> 5, ntile = t2 & 31; const int k0 = kt * 64;
                src = (k0 < 1024 ? p.w_a + (size_t)k0 * 2048 : p.w_b + (size_t)(k0 - 1024) * 2048) + ntile * 64; ld = 2048; dst = p.WabT + (size_t)(ntile * 64) * 2048 + k0; }
            else { const int t3 = t - 7168, kt = t3 >> 5, ntile = t3 & 31;
                src = p.w_out + (size_t)(kt * 64) * 2048 + ntile * 64; ld = 2048; dst = p.WoT + (size_t)(ntile * 64) * 2048 + kt * 64; }
        };
        float4 v[4][2], vn[4][2];
        int t0 = blockIdx.x * 4;
        if (t0 < 8192) {
#pragma unroll
            for (int u = 0; u < 4; ++u) { const float* src; bf16_t* dst; int ld; decode(t0 + u, src, dst, ld);
#pragma unroll
                for (int rep = 0; rep < 2; ++rep) v[u][rep] = *(const float4*)(src + (size_t)((tid >> 4) + rep * 32) * ld + (tid & 15) * 4); } }
#pragma unroll 1
        for (; t0 < 8192; t0 += gridDim.x * 4) {
            const int tn = t0 + (int)gridDim.x * 4;
            if (tn < 8192) {
#pragma unroll
                for (int u = 0; u < 4; ++u) { const float* src; bf16_t* dst; int ld; decode(tn + u, src, dst, ld);
#pragma unroll
                    for (int rep = 0; rep < 2; ++rep) vn[u][rep] = *(const float4*)(src + (size_t)((tid >> 4) + rep * 32) * ld + (tid & 15) * 4); } }
            lds_sync();
#pragma unroll
            for (int u = 0; u < 4; ++u)
#pragma unroll
                for (int rep = 0; rep < 2; ++rep) { float* tp = T + u * 4160 + ((tid >> 4) + rep * 32) * 65 + (tid & 15) * 4;
                    tp[0] = v[u][rep].x; tp[1] = v[u][rep].y; tp[2] = v[u][rep].z; tp[3] = v[u][rep].w; }
            lds_sync();
#pragma unroll
            for (int u = 0; u < 4; ++u) { const int n = tid >> 3, kc = (tid & 7) * 8; const float* tp = T + u * 4160; u32x4 w;
                const float* src; bf16_t* dst; int ld; decode(t0 + u, src, dst, ld);
                w.x = pk2(tp[(kc + 0) * 65 + n], tp[(kc + 1) * 65 + n]); w.y = pk2(tp[(kc + 2) * 65 + n], tp[(kc + 3) * 65 + n]);
                w.z = pk2(tp[(kc + 4) * 65 + n], tp[(kc + 5) * 65 + n]); w.w = pk2(tp[(kc + 6) * 65 + n], tp[(kc + 7) * 65 + n]);
                *(u32x4*)(dst + (size_t)n * 2048 + kc) = w; }
#pragma unroll
            for (int u = 0; u < 4; ++u) { v[u][0] = vn[u][0]; v[u][1] = vn[u][1]; }
        }
        lds_sync();
    }
    for (int i = blockIdx.x * NTHR + tid; i < 65536; i += gridDim.x * NTHR) p.KMEAN[i] = 0.f;
    float* Wsm = (float*)smem;
    for (int i = tid; i < 8192; i += NTHR) { const int k = i >> 2, g = i & 3; const int slot = ((k >> 8) * 4 + (k & 3)) * 64 + ((k >> 2) & 63);
        *(float4*)&Wsm[slot * 16 + 4 * ((g + (slot >> 2)) & 3)] = *(const float4*)&p.w_in[(size_t)k * INW + 4096 + g * 4]; }
    __syncthreads();
    for (int it = blockIdx.x; it < 1024; it += gridDim.x) {
        const int row0 = it * 16 + wid * 2;
        float ss0 = 0.f, ss1 = 0.f;
        float acc[2][16];
#pragma unroll
        for (int rr = 0; rr < 2; ++rr)
#pragma unroll
            for (int c = 0; c < 16; ++c) acc[rr][c] = 0.f;
        float4 xa[8], xb[8];
#pragma unroll
        for (int i = 0; i < 8; ++i) { xa[i] = *(const float4*)(p.x + (size_t)row0 * DM + i * 256 + lane * 4); xb[i] = *(const float4*)(p.x + (size_t)(row0 + 1) * DM + i * 256 + lane * 4); }
#pragma unroll 1
        for (int i = 0; i < 8; ++i) {
            const float4 w = *(const float4*)(p.pre_w + i * 256 + lane * 4);
            float4 a = xa[0], b = xb[0];
#pragma unroll
            for (int q = 1; q < 8; ++q) { if (i == q) { a = xa[q]; b = xb[q]; } }
            ss0 += a.x * a.x + a.y * a.y + a.z * a.z + a.w * a.w; ss1 += b.x * b.x + b.y * b.y + b.z * b.z + b.w * b.w;
            const float xav[4] = {a.x * w.x, a.y * w.y, a.z * w.z, a.w * w.w}, xbv[4] = {b.x * w.x, b.y * w.y, b.z * w.z, b.w * w.w};
#pragma unroll
            for (int j = 0; j < 4; ++j) { const int slot = (i * 4 + j) * 64 + lane;
#pragma unroll
                for (int g = 0; g < 4; ++g) { const float4 wv = *(const float4*)&Wsm[slot * 16 + 4 * ((g + (slot >> 2)) & 3)];
                    acc[0][g * 4 + 0] += xav[j] * wv.x; acc[0][g * 4 + 1] += xav[j] * wv.y; acc[0][g * 4 + 2] += xav[j] * wv.z; acc[0][g * 4 + 3] += xav[j] * wv.w;
                    acc[1][g * 4 + 0] += xbv[j] * wv.x; acc[1][g * 4 + 1] += xbv[j] * wv.y; acc[1][g * 4 + 2] += xbv[j] * wv.z; acc[1][g * 4 + 3] += xbv[j] * wv.w; } }
        }
        ss0 = wave_sum(ss0); ss1 = wave_sum(ss1);
        const float rs0 = rsqrtf(ss0 * (1.0f / 2048.0f) + 1e-6f), rs1 = rsqrtf(ss1 * (1.0f / 2048.0f) + 1e-6f);
#pragma unroll
        for (int i = 0; i < 8; ++i) {
            const float4 w = *(const float4*)(p.pre_w + i * 256 + lane * 4);
            const float4 a = xa[i], b = xb[i];
            u32x2 o; o.x = pk2(a.x * rs0 * w.x, a.y * rs0 * w.y); o.y = pk2(a.z * rs0 * w.z, a.w * rs0 * w.w);
            *(u32x2*)(p.H + (size_t)row0 * DM + i * 256 + lane * 4) = o;
            o.x = pk2(b.x * rs1 * w.x, b.y * rs1 * w.y); o.y = pk2(b.z * rs1 * w.z, b.w * rs1 * w.w);
            *(u32x2*)(p.H + (size_t)(row0 + 1) * DM + i * 256 + lane * 4) = o;
        }
#pragma unroll
        for (int rr = 0; rr < 2; ++rr) {
            float mine = 0.f;
#pragma unroll
            for (int c = 0; c < 16; ++c) { const float s = wave_sum(acc[rr][c]); mine = (lane == c) ? s : mine; }
            mine *= (rr == 0 ? rs0 : rs1);
            if (lane < 16) { const int row = row0 + rr, b = row >> 11, s = row & 2047;
                if (lane < 8) p.BETA[(size_t)(b * 8 + lane) * SEQ + s] = 1.0f / (1.0f + expf(-mine));
                else { const int hh = lane - 8; const float a = mine + p.dt_bias[hh]; const float sp = fmaxf(a, 0.f) + log1pf(expf(-fabsf(a)));
                    p.G[(size_t)(b * 8 + hh) * SEQ + s] = -expf(p.a_log[hh]) * sp; } }
        }
    }
}

__device__ __forceinline__ void phase_kmean(const Params& p, unsigned char* smem) {
    const int tid = threadIdx.x;
    float* red = (float*)smem;
    for (int task = blockIdx.x; task < 512; task += gridDim.x) {
        const int blk = task & 7, h = (task >> 3) & 7, b = task >> 6;
        const int dpair = tid & 63, sl = tid >> 6;
        const bf16_t* src = p.PROJ + (size_t)(b * SEQ + blk * 256 + sl * 32) * NPROJ + 4096 + 1024 + h * 128 + dpair * 2;
        float s0 = 0.f, s1 = 0.f;
#pragma unroll 8
        for (int i = 0; i < 32; ++i) { const unsigned w = *(const unsigned*)(src + (size_t)i * NPROJ); s0 += bflo(w); s1 += bfhi(w); }
        __syncthreads();
        red[sl * 128 + dpair * 2] = s0; red[sl * 128 + dpair * 2 + 1] = s1;
        __syncthreads();
        if (tid < 128) { float s = 0.f;
#pragma unroll
            for (int i = 0; i < 8; ++i) s += red[i * 128 + tid];
            p.KMEAN[(size_t)task * 128 + tid] = s * (1.0f / 256.0f); }
    }
}

__device__ __forceinline__ void gdn_naive(const Params& p, unsigned char* smem, int bh) {
    const int tid = threadIdx.x, e = tid & 127, dp = tid >> 7;
    bf16_t* sq = (bf16_t*)smem;
    bf16_t* sk = sq + 64 * 128;
    bf16_t* sv = sk + 64 * 128;
    float* sg = (float*)(smem + 49152);
    float* sb = sg + 64;
    float* red1 = sb + 64;
    float* red2 = red1 + 1024;
    float Sreg[32];
#pragma unroll
    for (int d = 0; d < 32; ++d) Sreg[d] = 0.f;
    const size_t base = (size_t)bh * SEQ * 128;
    const int b = bh >> 3, h = bh & 7;
    for (int ch = 0; ch < 32; ++ch) {
        __syncthreads();
#pragma unroll
        for (int i = 0; i < 2; ++i) { const int idx = tid + i * NTHR; const size_t g = base + (size_t)ch * 64 * 128 + (size_t)idx * 8;
            *(u32x4*)(sq + idx * 8) = *(const u32x4*)(p.GQ + g); *(u32x4*)(sk + idx * 8) = *(const u32x4*)(p.GK + g); *(u32x4*)(sv + idx * 8) = *(const u32x4*)(p.GV + g); }
        if (tid < 64) { sg[tid] = expf(p.G[(size_t)bh * SEQ + ch * 64 + tid]); sb[tid] = p.BETA[(size_t)bh * SEQ + ch * 64 + tid]; }
        __syncthreads();
        for (int t = 0; t < 64; ++t) {
            const int buf = t & 1;
            float kk[32], qq[32];
#pragma unroll
            for (int i = 0; i < 4; ++i) { const u32x4 kw = *(const u32x4*)(sk + t * 128 + dp * 32 + i * 8); const u32x4 qw = *(const u32x4*)(sq + t * 128 + dp * 32 + i * 8);
                kk[i * 8 + 0] = bflo(kw.x); kk[i * 8 + 1] = bfhi(kw.x); kk[i * 8 + 2] = bflo(kw.y); kk[i * 8 + 3] = bfhi(kw.y); kk[i * 8 + 4] = bflo(kw.z); kk[i * 8 + 5] = bfhi(kw.z); kk[i * 8 + 6] = bflo(kw.w); kk[i * 8 + 7] = bfhi(kw.w);
                qq[i * 8 + 0] = bflo(qw.x); qq[i * 8 + 1] = bfhi(qw.x); qq[i * 8 + 2] = bflo(qw.y); qq[i * 8 + 3] = bfhi(qw.y); qq[i * 8 + 4] = bflo(qw.z); qq[i * 8 + 5] = bfhi(qw.z); qq[i * 8 + 6] = bflo(qw.w); qq[i * 8 + 7] = bfhi(qw.w); }
            float part = 0.f;
#pragma unroll
            for (int d = 0; d < 32; ++d) part += Sreg[d] * kk[d];
            red1[(buf * 4 + dp) * 128 + e] = part;
            __syncthreads();
            if (dp == 0 && t > 0) { const int pb = buf ^ 1; const float o = red2[(pb * 4 + 0) * 128 + e] + red2[(pb * 4 + 1) * 128 + e] + red2[(pb * 4 + 2) * 128 + e] + red2[(pb * 4 + 3) * 128 + e];
                p.ORAW[(size_t)(b * SEQ + ch * 64 + t - 1) * 1024 + h * 128 + e] = f2bf(o); }
            const float eg = sg[t];
            const float Sk = (red1[(buf * 4 + 0) * 128 + e] + red1[(buf * 4 + 1) * 128 + e] + red1[(buf * 4 + 2) * 128 + e] + red1[(buf * 4 + 3) * 128 + e]) * eg;
            const float delta = sb[t] * (bf2f(sv[t * 128 + e]) - Sk);
            float po = 0.f;
#pragma unroll
            for (int d = 0; d < 32; ++d) { Sreg[d] = eg * Sreg[d] + kk[d] * delta; po += Sreg[d] * qq[d]; }
            red2[(buf * 4 + dp) * 128 + e] = po;
        }
        __syncthreads();
        if (dp == 0) { const float o = red2[(4 + 0) * 128 + e] + red2[(4 + 1) * 128 + e] + red2[(4 + 2) * 128 + e] + red2[(4 + 3) * 128 + e];
            p.ORAW[(size_t)(b * SEQ + ch * 64 + 63) * 1024 + h * 128 + e] = f2bf(o); }
    }
}

__device__ __forceinline__ void moba_task(const Params& p, unsigned char* smem, int bh, int qb) {
    int tid_o = threadIdx.x; asm volatile("" : "+v"(tid_o));
    const int tid = tid_o, wid = tid >> 6, lane = tid & 63, r16 = lane & 15, q4 = lane >> 4;
    bf16_t* Ks0 = (bf16_t*)smem;
    constexpr int KVB = 64 * 136 + 128 * 72;
    unsigned* sel = (unsigned*)(Ks0 + 2 * KVB);
    const int b = bh >> 3, h = bh & 7, t0 = qb * 256;
    const bf16_t* Pq = p.PROJ + (size_t)b * SEQ * NPROJ + 4096 + h * 128;
    const bf16_t* Pk = Pq + 1024; const bf16_t* Pv = Pq + 2048;
    lds_sync();
    const int n_own = 4, n_it = n_own + qb * 4;
    u32x4 pk_[2], pv_[2];
#define MOBA_ISSUE(IT) do { const int it_ = (IT); const bool own_ = it_ < n_own; const int blk_ = own_ ? qb : ((it_ - n_own) >> 2); const int kt_ = own_ ? it_ : ((it_ - n_own) & 3); \
        const int key0_ = blk_ * 256 + kt_ * 64; \
        _Pragma("unroll") for (int i_ = 0; i_ < 2; ++i_) { const int pc_ = tid + i_ * NTHR; \
            pk_[i_] = *(const u32x4*)(Pk + (size_t)(key0_ + (pc_ >> 4)) * NPROJ + (pc_ & 15) * 8); \
            pv_[i_] = *(const u32x4*)(Pv + (size_t)(key0_ + (pc_ & 63)) * NPROJ + (pc_ >> 6) * 8); } } while (0)
    MOBA_ISSUE(0);
    u32x4 gq[2][4], qraw[2][4];
#pragma unroll
    for (int ps = 0; ps < 2; ++ps) { const bf16_t* qr_ = Pq + (size_t)(t0 + (tid >> 2) + ps * 128) * NPROJ + (tid & 3) * 32;
#pragma unroll
        for (int i = 0; i < 4; ++i) gq[ps][i] = *(const u32x4*)(qr_ + i * 8); }
#pragma unroll
    for (int u = 0; u < 2; ++u) { const bf16_t* qr_ = Pq + (size_t)(t0 + wid * 32 + u * 16 + r16) * NPROJ + q4 * 8;
#pragma unroll
        for (int ks = 0; ks < 4; ++ks) qraw[u][ks] = *(const u32x4*)(qr_ + ks * 32); }
    float* kml = (float*)(sel + 256) + 2048;
    if (tid < 256) *(float4*)&kml[tid * 4] = *(const float4*)(p.KMEAN + (size_t)bh * 1024 + tid * 4);
    lds_sync();
#pragma unroll
    for (int pass = 0; pass < 2; ++pass) {
        const int qi = (tid >> 2) + pass * 128, part = tid & 3;
        float qv[32];
#pragma unroll
        for (int i = 0; i < 4; ++i) { const u32x4 w = gq[pass][i];
            qv[i * 8 + 0] = bflo(w.x); qv[i * 8 + 1] = bfhi(w.x); qv[i * 8 + 2] = bflo(w.y); qv[i * 8 + 3] = bfhi(w.y); qv[i * 8 + 4] = bflo(w.z); qv[i * 8 + 5] = bfhi(w.z); qv[i * 8 + 6] = bflo(w.w); qv[i * 8 + 7] = bfhi(w.w); }
        float* gl = (float*)(sel + 256);
#pragma unroll 1
        for (int j = 0; j < 7; ++j) { const float* km = kml + j * 128 + part * 32; float s = 0.f;
#pragma unroll
                for (int i = 0; i < 8; ++i) { const float4 kv = *(const float4*)(km + i * 4); s += qv[i * 4] * kv.x + qv[i * 4 + 1] * kv.y + qv[i * 4 + 2] * kv.z + qv[i * 4 + 3] * kv.w; }
                s += __shfl_xor(s, 1); s += __shfl_xor(s, 2); if (part == 0) gl[qi * 8 + j] = (j < qb) ? s : -3.0e38f; }
        unsigned m = 0;
        if (part == 0) {
            float gate[7];
#pragma unroll
            for (int j = 0; j < 7; ++j) gate[j] = gl[qi * 8 + j];
            if (qb <= 3) m = (1u << qb) - 1u;
            else {
#pragma unroll
                for (int r = 0; r < 3; ++r) { float best = -3.0e38f; int bi = 0;
#pragma unroll
                    for (int j = 0; j < 7; ++j) if (j < qb && !((m >> j) & 1u) && gate[j] > best) { best = gate[j]; bi = j; }
                    m |= 1u << bi; } }
        }
        if (part == 0) sel[qi] = m;
    }
    lds_sync();
    unsigned mysel[2]; int qpos[2];
    bf16x8 qf[2][4];
#pragma unroll
    for (int u = 0; u < 2; ++u) { const int myq = wid * 32 + u * 16 + r16; mysel[u] = sel[myq]; qpos[u] = myq;
        const bf16_t* qr = Pq + (size_t)(t0 + myq) * NPROJ + q4 * 8;
#pragma unroll
        for (int ks = 0; ks < 4; ++ks) { const u32x4 qw = qraw[u][ks];
            union { bf16x8 v; unsigned w[4]; } qs; const float scq = 0.08838834764831845f * 1.4426950408889634f;
            qs.w[0] = cvt_pk_bf16(bflo(qw.x) * scq, bfhi(qw.x) * scq); qs.w[1] = cvt_pk_bf16(bflo(qw.y) * scq, bfhi(qw.y) * scq);
            qs.w[2] = cvt_pk_bf16(bflo(qw.z) * scq, bfhi(qw.z) * scq); qs.w[3] = cvt_pk_bf16(bflo(qw.w) * scq, bfhi(qw.w) * scq);
            qf[u][ks] = qs.v; } }
    f32x4 O[2][8];
#pragma unroll
    for (int u = 0; u < 2; ++u)
#pragma unroll
        for (int mt = 0; mt < 8; ++mt) O[u][mt] = (f32x4){0.f, 0.f, 0.f, 0.f};
    float m_run[2] = {-1.0e30f, -1.0e30f}, l_run[2] = {0.f, 0.f};
    const float sc = 0.08838834764831845f * 1.4426950408889634f;
#define MOBA_WRITE(BUF) do { bf16_t* Kw_ = Ks0 + (BUF) * KVB; bf16_t* Vw_ = Kw_ + 64 * 136; \
        _Pragma("unroll") for (int i = 0; i < 2; ++i) { const int pc = tid + i * NTHR; \
            *(u32x4*)(Kw_ + (pc >> 4) * 136 + (pc & 15) * 8) = pk_[i]; \
            const u32x4 vv = pv_[i]; bf16_t* vt = Vw_ + ((pc >> 6) * 8) * 72 + (pc & 63); \
            vt[0 * 72] = (bf16_t)(vv.x & 0xffff); vt[1 * 72] = (bf16_t)(vv.x >> 16); vt[2 * 72] = (bf16_t)(vv.y & 0xffff); vt[3 * 72] = (bf16_t)(vv.y >> 16); \
            vt[4 * 72] = (bf16_t)(vv.z & 0xffff); vt[5 * 72] = (bf16_t)(vv.z >> 16); vt[6 * 72] = (bf16_t)(vv.w & 0xffff); vt[7 * 72] = (bf16_t)(vv.w >> 16); } } while (0)
    MOBA_WRITE(0);
    MOBA_ISSUE(1);
    lds_sync();
#pragma unroll 1
    for (int it = 0; it < n_it; ++it) {
        const bool own = it < n_own;
        const int blk = own ? qb : ((it - n_own) >> 2);
        const int kt = own ? it : ((it - n_own) & 3);
        if (it + 1 < n_it) { MOBA_WRITE((it + 1) & 1); if (it + 2 < n_it) MOBA_ISSUE(it + 2); }
        const bf16_t* Ks = Ks0 + (it & 1) * KVB; const bf16_t* VT = Ks + 64 * 136;
        const bool skip = own && (kt * 64 > wid * 32 + 31);
        if (!skip) {
            float offv[2];
#pragma unroll
            for (int u = 0; u < 2; ++u) { const bool okr = own || (((mysel[u] >> blk) & 1u) != 0u); offv[u] = okr ? fmaxf(m_run[u], -1.0e4f) : 3.0e38f; }
            f32x4 s[2][4];
#pragma unroll
            for (int nt = 0; nt < 4; ++nt) { s[0][nt] = (f32x4){-offv[0], -offv[0], -offv[0], -offv[0]}; s[1][nt] = (f32x4){-offv[1], -offv[1], -offv[1], -offv[1]};
#pragma unroll
                for (int ks = 0; ks < 4; ++ks) { const bf16x8 a = *(const bf16x8*)(Ks + (nt * 16 + r16) * 136 + ks * 32 + q4 * 8);
                    s[0][nt] = __builtin_amdgcn_mfma_f32_16x16x32_bf16(a, qf[0][ks], s[0][nt], 0, 0, 0);
                    s[1][nt] = __builtin_amdgcn_mfma_f32_16x16x32_bf16(a, qf[1][ks], s[1][nt], 0, 0, 0); } }
            union { bf16x8 v; unsigned w[4]; } pb[2][2];
#pragma unroll
            for (int u = 0; u < 2; ++u) {
                float tmax = -3.0e38f;
                if (own) {
#pragma unroll
                    for (int nt = 0; nt < 4; ++nt)
#pragma unroll
                        for (int j = 0; j < 4; ++j) { const int kin = kt * 64 + nt * 16 + q4 * 4 + j; const float xv = (kin <= qpos[u]) ? s[u][nt][j] : -3.0e38f; s[u][nt][j] = xv; tmax = fmaxf(tmax, xv); }
                } else {
#pragma unroll
                    for (int nt = 0; nt < 4; ++nt)
#pragma unroll
                        for (int j = 0; j < 4; ++j) tmax = fmaxf(tmax, s[u][nt][j]);
                }
                tmax = fmaxf(tmax, __shfl_xor(tmax, 16)); tmax = fmaxf(tmax, __shfl_xor(tmax, 32));
                if (!__all(tmax <= 6.0f)) {
                    const float d = fmaxf(tmax, 0.f);
                    const float m_new = (m_run[u] < -1.0e29f) ? (offv[u] + d) : (m_run[u] + d);
                    const float alpha = __builtin_amdgcn_exp2f(m_run[u] - m_new);
                    m_run[u] = m_new; l_run[u] *= alpha;
#pragma unroll
                    for (int mt = 0; mt < 8; ++mt) { O[u][mt][0] *= alpha; O[u][mt][1] *= alpha; O[u][mt][2] *= alpha; O[u][mt][3] *= alpha; }
#pragma unroll
                    for (int nt = 0; nt < 4; ++nt) { s[u][nt][0] -= d; s[u][nt][1] -= d; s[u][nt][2] -= d; s[u][nt][3] -= d; }
                }
                float psum = 0.f;
#pragma unroll
                for (int nt = 0; nt < 4; ++nt)
#pragma unroll
                    for (int j = 0; j < 4; ++j) { const float pv = __builtin_amdgcn_exp2f(s[u][nt][j]); s[u][nt][j] = pv; psum += pv; }
                l_run[u] += psum;
#pragma unroll
                for (int kk = 0; kk < 2; ++kk) {
                    pb[u][kk].w[0] = cvt_pk_bf16(s[u][2 * kk][0], s[u][2 * kk][1]); pb[u][kk].w[1] = cvt_pk_bf16(s[u][2 * kk][2], s[u][2 * kk][3]);
                    pb[u][kk].w[2] = cvt_pk_bf16(s[u][2 * kk + 1][0], s[u][2 * kk + 1][1]); pb[u][kk].w[3] = cvt_pk_bf16(s[u][2 * kk + 1][2], s[u][2 * kk + 1][3]); }
            }
#pragma unroll
            for (int kk = 0; kk < 2; ++kk)
#pragma unroll
                for (int mt = 0; mt < 8; ++mt) { const bf16_t* vr = VT + (mt * 16 + r16) * 72 + kk * 32 + q4 * 4;
                    union { bf16x8 v; u32x2 h[2]; } av; av.h[0] = *(const u32x2*)vr; av.h[1] = *(const u32x2*)(vr + 16);
                    O[0][mt] = __builtin_amdgcn_mfma_f32_16x16x32_bf16(av.v, pb[0][kk].v, O[0][mt], 0, 0, 0);
                    O[1][mt] = __builtin_amdgcn_mfma_f32_16x16x32_bf16(av.v, pb[1][kk].v, O[1][mt], 0, 0, 0); }
        }
        lds_sync();
    }
#undef MOBA_ISSUE
#undef MOBA_WRITE
#pragma unroll
    for (int u = 0; u < 2; ++u) {
        float l = l_run[u]; l += __shfl_xor(l, 16); l += __shfl_xor(l, 32);
        const float inv = 1.0f / l;
        const size_t tok = (size_t)b * SEQ + t0 + wid * 32 + u * 16 + r16;
#pragma unroll
        for (int mt = 0; mt < 8; ++mt) { const int d0 = mt * 16 + q4 * 4;
            const u32x2 zw = *(const u32x2*)(p.PROJ + tok * NPROJ + 7168 + h * 128 + d0);
            u32x2 o; o.x = pk2(O[u][mt][0] * inv * bflo(zw.x), O[u][mt][1] * inv * bfhi(zw.x)); o.y = pk2(O[u][mt][2] * inv * bflo(zw.y), O[u][mt][3] * inv * bfhi(zw.y));
            *(u32x2*)(p.AB + tok * DM + 1024 + h * 128 + d0) = o; }
    }
}

__device__ __forceinline__ bf16x8 gather_kn(const bf16_t* base, int ld, int k0, int n) {
    union { bf16x8 v; bf16_t s[8]; } u;
#pragma unroll
    for (int j = 0; j < 8; ++j) u.s[j] = base[(k0 + j) * ld + n];
    return u.v;
}
struct CPRegs { u32x4 xw[3][2][4]; float g_in, b_in; };
__device__ __forceinline__ void cp_issue(const Params& p, int task, int tid, CPRegs& R) {
    const int bh = task >> 5, ch = task & 31, b = bh >> 3, h = bh & 7, sch0 = ch * 64;
    const size_t token0 = (size_t)b * SEQ + ch * 64;
#pragma unroll
    for (int mat = 0; mat < 3; ++mat)
#pragma unroll
        for (int i = 0; i < 2; ++i) { const int row = (tid + i * NTHR) >> 4;
#pragma unroll
            for (int j = 0; j < 4; ++j) { const bool ok = (sch0 + row - 3 + j >= 0); const size_t tr = ok ? (token0 + row + j) - 3 : token0;
                R.xw[mat][i][j] = *(const u32x4*)(p.PROJ + tr * NPROJ + mat * 1024 + h * 128 + (tid & 15) * 8); if (!ok) R.xw[mat][i][j] = (u32x4){0u, 0u, 0u, 0u}; } }
    R.g_in = 0.f; R.b_in = 0.f;
    if (tid < 64) { R.g_in = p.G[(size_t)bh * SEQ + ch * 64 + tid]; R.b_in = p.BETA[(size_t)bh * SEQ + ch * 64 + tid]; }
}
__device__ __forceinline__ void gdn_chunk_prep(const Params& p, unsigned char* smem, int task, int next_task, CPRegs& R, int& cw_h) {
    int tid_o = threadIdx.x; asm volatile("" : "+v"(tid_o));
    const int tid = tid_o, wid = tid >> 6, lane = tid & 63, r16 = lane & 15, q4 = lane >> 4;
    bf16_t* Qs = (bf16_t*)smem; bf16_t* Ks = Qs + 64 * 136; bf16_t* Vs = Ks + 64 * 136; bf16_t* KBs = Vs + 64 * 136;
    float* Lm = (float*)(smem + 69632); float* Tm = Lm + 64 * 65; float* Mm = Tm + 64 * 65;
    bf16_t* Tb = (bf16_t*)(smem + 119552);
    float* gcs = (float*)(smem + 128768); float* bts = gcs + 64;
    const int bh = task >> 5, ch = task & 31, b = bh >> 3, h = bh & 7;
    float* cwl = (float*)(smem + 132096);
    if (h != cw_h) {
        lds_sync();
        if (tid < 384) { const int mat = tid >> 7, rem = tid & 127, j = rem >> 5, c4 = (rem & 31) * 4;
            *(float4*)&cwl[(mat * 4 + j) * 128 + c4] = *(const float4*)(p.conv_w + j * 3072 + mat * 1024 + h * 128 + c4); }
        cw_h = h;
    }
    const size_t cbase = ((size_t)bh * SEQ + ch * 64) * 128;
    const size_t token0 = (size_t)b * SEQ + ch * 64;
    lds_sync();
    if (tid < 64) { gcs[tid] = R.g_in; bts[tid] = R.b_in; }
    for (int i = tid; i < 64 * 72 / 2; i += NTHR) ((unsigned*)Tb)[i] = 0u;
    lds_sync();
    if (tid < 64) { float gcv = gcs[tid];
#pragma unroll
        for (int o = 1; o < 64; o <<= 1) { const float t = __shfl_up(gcv, o); if (lane >= o) gcv += t; }
        gcs[tid] = gcv; }
    lds_sync();
    const float gl = gcs[63];
    {
        const int piece = tid & 15;
#pragma unroll
        for (int mat = 0; mat < 3; ++mat) {
            const int col = mat * 1024 + h * 128 + piece * 8;
            float acc2[2][8];
#pragma unroll
            for (int i = 0; i < 2; ++i)
#pragma unroll
                for (int c = 0; c < 8; ++c) acc2[i][c] = 0.f;
#pragma unroll
            for (int j = 0; j < 4; ++j) { const float4 w0 = *(const float4*)&cwl[(mat * 4 + j) * 128 + piece * 8], w1 = *(const float4*)&cwl[(mat * 4 + j) * 128 + piece * 8 + 4];
#pragma unroll
                for (int i = 0; i < 2; ++i) { const u32x4 xv = R.xw[mat][i][j];
                    acc2[i][0] += w0.x * bflo(xv.x); acc2[i][1] += w0.y * bfhi(xv.x); acc2[i][2] += w0.z * bflo(xv.y); acc2[i][3] += w0.w * bfhi(xv.y);
                    acc2[i][4] += w1.x * bflo(xv.z); acc2[i][5] += w1.y * bfhi(xv.z); acc2[i][6] += w1.z * bflo(xv.w); acc2[i][7] += w1.w * bfhi(xv.w); } }
#pragma unroll
            for (int i = 0; i < 2; ++i) { const int idx = tid + i * NTHR, row = idx >> 4;
                float a[8];
#pragma unroll
                for (int c = 0; c < 8; ++c) a[c] = acc2[i][c];
                float ss = 0.f;
#pragma unroll
                for (int c = 0; c < 8; ++c) { a[c] = a[c] * __builtin_amdgcn_rcpf(1.0f + __expf(-a[c])); ss += a[c] * a[c]; }
                const float eg = __expf(gcs[row]), bt = bts[row];
                if (mat < 2) { ss += __shfl_xor(ss, 1); ss += __shfl_xor(ss, 2); ss += __shfl_xor(ss, 4); ss += __shfl_xor(ss, 8);
                    float sc = rsqrtf(ss + 1e-6f); if (mat == 0) sc *= 0.08838834764831845f;
#pragma unroll
                    for (int c = 0; c < 8; ++c) a[c] *= sc; }
                u32x4 o;
                if (mat == 0) {
                    o.x = cvt_pk_bf16(a[0], a[1]); o.y = cvt_pk_bf16(a[2], a[3]); o.z = cvt_pk_bf16(a[4], a[5]); o.w = cvt_pk_bf16(a[6], a[7]);
                    *(u32x4*)(Qs + row * 136 + piece * 8) = o;
                    o.x = cvt_pk_bf16(a[0] * eg, a[1] * eg); o.y = cvt_pk_bf16(a[2] * eg, a[3] * eg); o.z = cvt_pk_bf16(a[4] * eg, a[5] * eg); o.w = cvt_pk_bf16(a[6] * eg, a[7] * eg);
                    *(u32x4*)(p.GQ + cbase + (size_t)idx * 8) = o;
                } else if (mat == 1) {
                    o.x = cvt_pk_bf16(a[0], a[1]); o.y = cvt_pk_bf16(a[2], a[3]); o.z = cvt_pk_bf16(a[4], a[5]); o.w = cvt_pk_bf16(a[6], a[7]);
                    *(u32x4*)(Ks + row * 136 + piece * 8) = o;
                    const float kb = bt * eg;
                    o.x = cvt_pk_bf16(a[0] * kb, a[1] * kb); o.y = cvt_pk_bf16(a[2] * kb, a[3] * kb); o.z = cvt_pk_bf16(a[4] * kb, a[5] * kb); o.w = cvt_pk_bf16(a[6] * kb, a[7] * kb);
                    *(u32x4*)(KBs + row * 136 + piece * 8) = o;
                } else {
                    o.x = cvt_pk_bf16(a[0] * bt, a[1] * bt); o.y = cvt_pk_bf16(a[2] * bt, a[3] * bt); o.z = cvt_pk_bf16(a[4] * bt, a[5] * bt); o.w = cvt_pk_bf16(a[6] * bt, a[7] * bt);
                    *(u32x4*)(Vs + row * 136 + piece * 8) = o;
                }
            }
        }
    }
    if (next_task >= 0) cp_issue(p, next_task, tid, R);
    lds_sync();
    {
        const int mat = wid >> 2, ti = wid & 3;
        const bf16_t* As = mat ? Qs : Ks;
        bf16x8 af[4];
#pragma unroll
        for (int ks = 0; ks < 4; ++ks) af[ks] = *(const bf16x8*)(As + (ti * 16 + r16) * 136 + ks * 32 + q4 * 8);
#pragma unroll
        for (int tj = 0; tj < 4; ++tj) {
            f32x4 acc = (f32x4){0.f, 0.f, 0.f, 0.f};
            if (tj <= ti) {
#pragma unroll
                for (int ks = 0; ks < 4; ++ks) { const bf16x8 bfr = *(const bf16x8*)(Ks + (tj * 16 + r16) * 136 + ks * 32 + q4 * 8);
                    acc = __builtin_amdgcn_mfma_f32_16x16x32_bf16(af[ks], bfr, acc, 0, 0, 0); } }
            const int jj = tj * 16 + r16; const float gj = gcs[jj];
#pragma unroll
            for (int j = 0; j < 4; ++j) { const int i = ti * 16 + q4 * 4 + j;
                if (mat == 0) { const float v = (jj < i) ? bts[i] * acc[j] * __expf(gcs[i] - gj) : 0.f; Lm[i * 65 + jj] = v; }
                else { const float v = (jj <= i) ? acc[j] * __expf(gcs[i] - gj) : 0.f; p.AB[(token0 + i) * DM + h * 64 + jj] = f2bf(v); } }
        }
    }
    lds_sync();
    if (tid < 64) { const int blk = tid >> 4, c = tid & 15; float t[16];
#pragma unroll
        for (int i = 0; i < 16; ++i) { float a = (i == c) ? 1.f : 0.f;
#pragma unroll
            for (int j = 0; j < 16; ++j) if (j < i) a -= Lm[(blk * 16 + i) * 65 + blk * 16 + j] * t[j];
            t[i] = a; Tm[(blk * 16 + i) * 65 + blk * 16 + c] = a; } }
    lds_sync();
#pragma unroll
    for (int d = 1; d < 4; ++d) {
        if (wid < 4 - d) { const int bj = wid, bi = bj + d;
            f32x4 am = (f32x4){0.f, 0.f, 0.f, 0.f};
#pragma unroll
            for (int kk = 0; kk < 4 * d; ++kk) { const float av = Lm[(bi * 16 + r16) * 65 + bj * 16 + kk * 4 + q4]; const float bv = Tm[(bj * 16 + kk * 4 + q4) * 65 + bj * 16 + r16];
                am = __builtin_amdgcn_mfma_f32_16x16x4f32(av, bv, am, 0, 0, 0); }
#pragma unroll
            for (int j = 0; j < 4; ++j) Mm[(bi * 16 + q4 * 4 + j) * 65 + bj * 16 + r16] = am[j];
            asm volatile("s_waitcnt lgkmcnt(0)" ::: "memory");
            f32x4 at = (f32x4){0.f, 0.f, 0.f, 0.f};
#pragma unroll
            for (int kk = 0; kk < 4; ++kk) { const float av = Tm[(bi * 16 + r16) * 65 + bi * 16 + kk * 4 + q4]; const float bv = Mm[(bi * 16 + kk * 4 + q4) * 65 + bj * 16 + r16];
                at = __builtin_amdgcn_mfma_f32_16x16x4f32(av, bv, at, 0, 0, 0); }
#pragma unroll
            for (int j = 0; j < 4; ++j) Tm[(bi * 16 + q4 * 4 + j) * 65 + bj * 16 + r16] = -at[j];
        }
        lds_sync();
    }
    for (int idx = tid; idx < 4096; idx += NTHR) { const int i = idx >> 6, j = idx & 63; if ((j >> 4) <= (i >> 4)) Tb[i * 72 + j] = f2bf(Tm[i * 65 + j]); }
    lds_sync();
    {
        const int tn = wid;
        bf16x8 bu[2], bw[2];
#pragma unroll
        for (int ks = 0; ks < 2; ++ks) { bu[ks] = gather_kn(Vs, 136, ks * 32 + q4 * 8, tn * 16 + r16); bw[ks] = gather_kn(KBs, 136, ks * 32 + q4 * 8, tn * 16 + r16); }
#pragma unroll
        for (int ti = 0; ti < 4; ++ti) {
            f32x4 au = (f32x4){0.f, 0.f, 0.f, 0.f}, aw = (f32x4){0.f, 0.f, 0.f, 0.f};
#pragma unroll
            for (int ks = 0; ks < 2; ++ks) if (ks * 2 <= ti) { const bf16x8 a = *(const bf16x8*)(Tb + (ti * 16 + r16) * 72 + ks * 32 + q4 * 8);
                au = __builtin_amdgcn_mfma_f32_16x16x32_bf16(a, bu[ks], au, 0, 0, 0); aw = __builtin_amdgcn_mfma_f32_16x16x32_bf16(a, bw[ks], aw, 0, 0, 0); }
            u32x2 o; o.x = cvt_pk_bf16(au[0], au[1]); o.y = cvt_pk_bf16(au[2], au[3]);
            *(u32x2*)(p.GV + cbase + (size_t)(tn * 16 + r16) * 64 + ti * 16 + q4 * 4) = o;
#pragma unroll
            for (int j = 0; j < 4; ++j) p.WN[((size_t)task * 64 + ti * 16 + q4 * 4 + j) * 128 + tn * 16 + r16] = f2bf(-aw[j]);
        }
    }
    { const int d = tid >> 2, cg = (tid & 3) * 16; unsigned w[8];
#pragma unroll
        for (int c2 = 0; c2 < 8; ++c2) { const int c = cg + c2 * 2;
            w[c2] = cvt_pk_bf16(bf2f(Ks[c * 136 + d]) * __expf(gl - gcs[c]), bf2f(Ks[(c + 1) * 136 + d]) * __expf(gl - gcs[c + 1])); }
        u32x4 o0, o1; o0.x = w[0]; o0.y = w[1]; o0.z = w[2]; o0.w = w[3]; o1.x = w[4]; o1.y = w[5]; o1.z = w[6]; o1.w = w[7];
        *(u32x4*)(p.GK + cbase + (size_t)d * 64 + cg) = o0; *(u32x4*)(p.GK + cbase + (size_t)d * 64 + cg + 8) = o1; }
    if (tid == 0) p.GL[task] = __expf(gl);
}

__device__ __forceinline__ void gdn_scan(const Params& p, unsigned char* smem, int item) {
    int tid_o = threadIdx.x; asm volatile("" : "+v"(tid_o));
    const int tid = tid_o, wid = tid >> 6, lane = tid & 63, r16 = lane & 15, q4 = lane >> 4;
    const int bh = item >> 2, es = item & 3, b = bh >> 3, h = bh & 7;
    constexpr int SETSZ = 64 * 136 * 2 + 128 * 72 + 64 * 72 + 32 * 136 + 32 * 72;
    const int ci = wid >> 1, et = wid & 1;
    f32x4 Sacc[2]; Sacc[0] = (f32x4){0.f, 0.f, 0.f, 0.f}; Sacc[1] = (f32x4){0.f, 0.f, 0.f, 0.f};
    struct ScanRegs { u32x4 rw[2], rq[2], rk[2], ri; u32x2 ru; float rgl; };
    const int irow = tid >> 3, ipiece = tid & 7;
    auto issue = [&](int n, ScanRegs& R) {
        const int task_ = bh * 32 + n; const size_t cb_ = ((size_t)bh * SEQ + (size_t)n * 64) * 128;
#pragma unroll
        for (int i_ = 0; i_ < 2; ++i_) { const size_t o_ = (size_t)(tid + i_ * NTHR) * 8;
            R.rw[i_] = *(const u32x4*)(p.WN + (size_t)task_ * 8192 + o_); R.rq[i_] = *(const u32x4*)(p.GQ + cb_ + o_); R.rk[i_] = *(const u32x4*)(p.GK + cb_ + o_); }
        R.ri = *(const u32x4*)(p.AB + ((size_t)b * SEQ + (size_t)n * 64 + irow) * DM + h * 64 + ipiece * 8);
        R.ru = *(const u32x2*)(p.GV + cb_ + (size_t)(es * 32 + et * 16 + r16) * 64 + ci * 16 + q4 * 4);
        R.rgl = p.GL[task_];
    };
    auto body = [&](int n, ScanRegs& R) {
        bf16_t* Ws = (bf16_t*)smem + (n & 1) * SETSZ; bf16_t* QGs = Ws + 64 * 136; bf16_t* KDs = QGs + 64 * 136; bf16_t* INs = KDs + 128 * 72; bf16_t* STs = INs + 64 * 72; bf16_t* VNs = STs + 32 * 136;
#pragma unroll
        for (int i = 0; i < 2; ++i) { const int idx = tid + i * NTHR;
            *(u32x4*)(Ws + (idx >> 4) * 136 + (idx & 15) * 8) = R.rw[i]; *(u32x4*)(QGs + (idx >> 4) * 136 + (idx & 15) * 8) = R.rq[i];
            *(u32x4*)(KDs + (idx >> 3) * 72 + (idx & 7) * 8) = R.rk[i]; }
        *(u32x4*)(INs + irow * 72 + ipiece * 8) = R.ri;
#pragma unroll
        for (int e2 = 0; e2 < 2; ++e2) { u32x2 o; o.x = pk2(Sacc[e2][0], Sacc[e2][1]); o.y = pk2(Sacc[e2][2], Sacc[e2][3]);
            *(u32x2*)(STs + (e2 * 16 + r16) * 136 + wid * 16 + q4 * 4) = o; }
        const u32x2 ucur = R.ru; const float glc = R.rgl;
        lds_sync();
        if (n + 2 < 32) issue(n + 2, R);
        f32x4 vn; vn[0] = bflo(ucur.x); vn[1] = bfhi(ucur.x); vn[2] = bflo(ucur.y); vn[3] = bfhi(ucur.y);
#pragma unroll
        for (int ks = 0; ks < 4; ++ks) { const bf16x8 a = *(const bf16x8*)(Ws + (ci * 16 + r16) * 136 + ks * 32 + q4 * 8); const bf16x8 bb = *(const bf16x8*)(STs + (et * 16 + r16) * 136 + ks * 32 + q4 * 8);
            vn = __builtin_amdgcn_mfma_f32_16x16x32_bf16(a, bb, vn, 0, 0, 0); }
        { u32x2 o; o.x = pk2(vn[0], vn[1]); o.y = pk2(vn[2], vn[3]); *(u32x2*)(VNs + (et * 16 + r16) * 72 + ci * 16 + q4 * 4) = o; }
        lds_sync();
        f32x4 oo = (f32x4){0.f, 0.f, 0.f, 0.f};
#pragma unroll
        for (int ks = 0; ks < 4; ++ks) { const bf16x8 a = *(const bf16x8*)(STs + (et * 16 + r16) * 136 + ks * 32 + q4 * 8); const bf16x8 bb = *(const bf16x8*)(QGs + (ci * 16 + r16) * 136 + ks * 32 + q4 * 8);
            oo = __builtin_amdgcn_mfma_f32_16x16x32_bf16(a, bb, oo, 0, 0, 0); }
#pragma unroll
        for (int ks = 0; ks < 2; ++ks) { const bf16x8 a = *(const bf16x8*)(VNs + (et * 16 + r16) * 72 + ks * 32 + q4 * 8); const bf16x8 bb = *(const bf16x8*)(INs + (ci * 16 + r16) * 72 + ks * 32 + q4 * 8);
            oo = __builtin_amdgcn_mfma_f32_16x16x32_bf16(a, bb, oo, 0, 0, 0); }
        { u32x2 o; o.x = pk2(oo[0], oo[1]); o.y = pk2(oo[2], oo[3]);
            __hip_atomic_store((unsigned long long*)(p.ORAW + ((size_t)b * SEQ + (size_t)n * 64 + ci * 16 + r16) * 1024 + h * 128 + es * 32 + et * 16 + q4 * 4), ((unsigned long long)o.y << 32) | (unsigned long long)o.x, __ATOMIC_RELAXED, __HIP_MEMORY_SCOPE_AGENT); }
#pragma unroll
        for (int e2 = 0; e2 < 2; ++e2) { Sacc[e2][0] *= glc; Sacc[e2][1] *= glc; Sacc[e2][2] *= glc; Sacc[e2][3] *= glc;
#pragma unroll
            for (int ks = 0; ks < 2; ++ks) { const bf16x8 a = *(const bf16x8*)(KDs + (wid * 16 + r16) * 72 + ks * 32 + q4 * 8); const bf16x8 bb = *(const bf16x8*)(VNs + (e2 * 16 + r16) * 72 + ks * 32 + q4 * 8);
                Sacc[e2] = __builtin_amdgcn_mfma_f32_16x16x32_bf16(a, bb, Sacc[e2], 0, 0, 0); } }
    };
    ScanRegs r0, r1;
    issue(0, r0); issue(1, r1);
#pragma unroll 1
    for (int n = 0; n < 32; n += 2) { body(n, r0); body(n + 1, r1); }
}

__device__ __forceinline__ void phase_mix(const Params& p, unsigned char* smem) {
    { CPRegs R; int cw_h = -1; int t = blockIdx.x; if (t < 2048) cp_issue(p, t, threadIdx.x, R);
#pragma unroll 1
      for (; t < 2048; t += gridDim.x) { const int nt = t + (int)gridDim.x; gdn_chunk_prep(p, smem, t, nt < 2048 ? nt : -1, R, cw_h); } }
}
__device__ __forceinline__ void oanorm_part(const Params& p, int bh, int es);
__device__ __forceinline__ void phase_scan(const Params& p, unsigned char* smem) {
    const int wq = blockIdx.x >> 3, bh = (blockIdx.x & 7) * 8 + (wq >> 2), sub = wq & 3;
#pragma unroll 1
    for (int rep = 0; rep < SCAN_REPEAT; ++rep) gdn_scan(p, smem, bh * 4 + sub);
    flag_arrive(p.BAR + 64 + bh * 64);
#pragma unroll 1
    for (int rep = 0; rep < MOBA_REPEAT; ++rep) { moba_task(p, smem, bh, 7 - sub); moba_task(p, smem, bh, sub); }
    { const int hh = bh & 7, b8 = bh & ~7; const int h1 = hh < 4 ? 2 * hh : hh, h2 = hh < 4 ? 2 * hh + 1 : hh;
      flag_wait3(p.BAR + 64 + bh * 64, p.BAR + 64 + (b8 + h1) * 64, p.BAR + 64 + (b8 + h2) * 64, 4); }
    oanorm_part(p, bh, sub);
}

__device__ __forceinline__ void oanorm_part(const Params& p, int bh, int es) {
    const int wid = threadIdx.x >> 6, lane = threadIdx.x & 63;
    const int b = bh >> 3, h = bh & 7;
    const int cl = (lane & 7) * 16, c0 = h * 128 + cl;
    float nw[16];
#pragma unroll
    for (int i = 0; i < 4; ++i) { const float4 w = *(const float4*)(p.gdn_nw + cl + i * 4); nw[i * 4] = w.x; nw[i * 4 + 1] = w.y; nw[i * 4 + 2] = w.z; nw[i * 4 + 3] = w.w; }
#pragma unroll 2
    for (int itr = 0; itr < 8; ++itr) {
        const size_t tok = (size_t)b * SEQ + es * 512 + itr * 64 + wid * 8 + (lane >> 3);
        const u32x4 o0 = *(const u32x4*)(p.ORAW + tok * 1024 + c0), o1 = *(const u32x4*)(p.ORAW + tok * 1024 + c0 + 8);
        const u32x4 z0 = *(const u32x4*)(p.PROJ + tok * NPROJ + 3072 + c0), z1 = *(const u32x4*)(p.PROJ + tok * NPROJ + 3072 + c0 + 8);
        float o[16] = {bflo(o0.x), bfhi(o0.x), bflo(o0.y), bfhi(o0.y), bflo(o0.z), bfhi(o0.z), bflo(o0.w), bfhi(o0.w), bflo(o1.x), bfhi(o1.x), bflo(o1.y), bfhi(o1.y), bflo(o1.z), bfhi(o1.z), bflo(o1.w), bfhi(o1.w)};
        const float z[16] = {bflo(z0.x), bfhi(z0.x), bflo(z0.y), bfhi(z0.y), bflo(z0.z), bfhi(z0.z), bflo(z0.w), bfhi(z0.w), bflo(z1.x), bfhi(z1.x), bflo(z1.y), bfhi(z1.y), bflo(z1.z), bfhi(z1.z), bflo(z1.w), bfhi(z1.w)};
        float ss = 0.f;
#pragma unroll
        for (int i = 0; i < 16; ++i) ss += o[i] * o[i];
        ss += __shfl_xor(ss, 1); ss += __shfl_xor(ss, 2); ss += __shfl_xor(ss, 4);
        const float r = rsqrtf(ss * (1.0f / 128.0f) + 1e-6f);
#pragma unroll
        for (int i = 0; i < 16; ++i) o[i] = o[i] * r * nw[i] * z[i];
        u32x4 w0, w1; w0.x = pk2(o[0], o[1]); w0.y = pk2(o[2], o[3]); w0.z = pk2(o[4], o[5]); w0.w = pk2(o[6], o[7]); w1.x = pk2(o[8], o[9]); w1.y = pk2(o[10], o[11]); w1.z = pk2(o[12], o[13]); w1.w = pk2(o[14], o[15]);
        *(u32x4*)(p.AB + tok * DM + c0) = w0; *(u32x4*)(p.AB + tok * DM + c0 + 8) = w1;
    }
}

__device__ __forceinline__ void phase_final(const Params& p) {
    const int wid = threadIdx.x >> 6, lane = threadIdx.x & 63;
    for (int row = blockIdx.x * 8 + wid; row < MTOK; row += gridDim.x * 8) {
        float ss = (lane < 32) ? p.RSS[(size_t)row * 32 + lane] : 0.f;
        ss = wave_sum(ss);
        const float rs = rsqrtf(ss * (1.0f / 2048.0f) + 1e-6f);
#pragma unroll
        for (int i = 0; i < 8; ++i) { const int c = i * 256 + lane * 4;
            const float4 xv = *(const float4*)(p.x + (size_t)row * DM + c); const float4 w = *(const float4*)(p.post_w + c);
            const u32x2 yw = *(const u32x2*)(p.Y + (size_t)row * DM + c);
            float4 o; o.x = xv.x + bflo(yw.x) * rs * w.x; o.y = xv.y + bfhi(yw.x) * rs * w.y; o.z = xv.z + bflo(yw.y) * rs * w.z; o.w = xv.w + bfhi(yw.y) * rs * w.w;
            *(float4*)(p.out + (size_t)row * DM + c) = o; }
    }
}

template <int PH> __device__ __forceinline__ void run_phase(const Params& p, unsigned char* smem) {
    if (PH == 0) phase_prep(p, smem);
    else if (PH == 1) { gm::Order S; S.init(MTOK, N1, gridDim.x, blockIdx.x, 0, WGM_G1); gm::EpiProj E{p.PROJ, p.GR, p.GB, p.KMEAN}; gm::gemm_phase(( LAS unsigned char*)smem, p.H, p.WinT, 32, S, E); }
    else if (PH == 2) phase_mix(p, smem);
    else if (PH == 3) phase_scan(p, smem);
    else if (PH == 4) { gm::Order S; S.init(MTOK, DM, gridDim.x, blockIdx.x, 1, WGM_G2); gm::EpiMerge E{p.GR, p.GB, p.MERGED}; gm::gemm_phase((LAS unsigned char*)smem, p.AB, p.WabT, 16, S, E); }
    else if (PH == 5) { gm::Order S; S.init(MTOK, DM, gridDim.x, blockIdx.x, 0, WGM_G3); gm::EpiY E{p.Y, p.RSS}; gm::gemm_phase((LAS unsigned char*)smem, p.MERGED, p.WoT, 32, S, E); }
    else phase_final(p);
}

#if ONE_LAUNCH
__global__ void __launch_bounds__(NTHR, 2) fwd_mega(Params p) {
    extern __shared__ __attribute__((aligned(16))) unsigned char smem[];
    cg::grid_group grid = cg::this_grid();
#define RUNP(k) do { run_phase<k>(p, smem); if ((REPEAT_MASK >> k) & 1) { grid.sync(); run_phase<k>(p, smem); } } while (0)
    if (p.BAR == nullptr) grid.sync();
    volatile LAS unsigned* xst = (volatile LAS unsigned*)((LAS unsigned char*)smem + LDS_BYTES);
    if (threadIdx.x == 0) { xst[0] = 0u; xst[1] = 0u; xst[2] = 0u; xst[3] = 0u; }
    __syncthreads();
    const XcdBarrier xb = xcd_barrier_post(p.BAR + 8192, xst);
    RUNP(0); xcd_barrier(xb);
    RUNP(1); xcd_barrier(xb);
    RUNP(2); xcd_barrier(xb);
    RUNP(3); xcd_barrier(xb);
    RUNP(4); xcd_barrier(xb);
    RUNP(5); xcd_barrier(xb);
    run_phase<6>(p, smem);
}
#else
template <int PH> __global__ void __launch_bounds__(NTHR, 2) k_phase(Params p) {
    extern __shared__ __attribute__((aligned(16))) unsigned char smem[];
    run_phase<PH>(p, smem);
}
#endif

extern "C" void kernel_launch(void* const* d_in, const int* in_sizes, int n_in, void* d_out, int out_size, void* d_ws, size_t ws_size, hipStream_t stream) {
    if (ws_size < 500 * MiB) { fprintf(stderr, "kernel_launch: workspace too small (%zu); this kernel's workspace map ends at 500 MiB\n", ws_size); return; }
    Params p{};
    p.x = (const float*)d_in[0]; p.pre_w = (const float*)d_in[1]; p.w_in = (const float*)d_in[2]; p.conv_w = (const float*)d_in[3];
    p.a_log = (const float*)d_in[4]; p.dt_bias = (const float*)d_in[5]; p.gdn_nw = (const float*)d_in[6]; p.w_a = (const float*)d_in[7];
    p.w_b = (const float*)d_in[8]; p.w_out = (const float*)d_in[9]; p.post_w = (const float*)d_in[10];
    p.out = (float*)d_out;
    unsigned char* ws = (unsigned char*)d_ws; unsigned char* ob = (unsigned char*)d_out;
    p.PROJ = (bf16_t*)(ws); p.Y = (bf16_t*)(ws); p.GR = (bf16_t*)(ws + 256 * MiB); p.GB = (bf16_t*)(ws + 320 * MiB);
    p.WabT = (bf16_t*)(ws + 384 * MiB); p.WoT = (bf16_t*)(ws + 392 * MiB);
    p.BETA = (float*)(ws + 400 * MiB); p.G = (float*)(ws + 400 * MiB + MiB / 2); p.KMEAN = (float*)(ws + 401 * MiB); p.GL = (float*)(ws + 401 * MiB + MiB / 2); p.BAR = (unsigned*)(ws + 401 * MiB + 3 * MiB / 4); p.WN = (bf16_t*)(ws + 468 * MiB); p.RSS = (float*)(ws + 402 * MiB);
    p.WinT = (bf16_t*)(ws + 404 * MiB); p.AB = (bf16_t*)(ws + 404 * MiB);
    p.H = (bf16_t*)(ob); p.GQ = (bf16_t*)(ob); p.GK = (bf16_t*)(ob + 32 * MiB); p.GV = (bf16_t*)(ob + 64 * MiB); p.ORAW = (bf16_t*)(ob + 96 * MiB);
    p.MERGED = (bf16_t*)(ob);
#if ONE_LAUNCH
    static int grid_blocks = 0;
    if (!grid_blocks) {
        int dev = 0, cus = 0, per_cu = 0;
        hipGetDevice(&dev); hipDeviceGetAttribute(&cus, hipDeviceAttributeMultiprocessorCount, dev);
        hipFuncSetAttribute((const void*)fwd_mega, hipFuncAttributeMaxDynamicSharedMemorySize, LDS_BYTES + 16);
        hipOccupancyMaxActiveBlocksPerMultiprocessor(&per_cu, (const void*)fwd_mega, NTHR, LDS_BYTES + 16);
        if (per_cu < 1) per_cu = 1;
        grid_blocks = cus * per_cu;
        if (grid_blocks > 256) grid_blocks = 256;
    }
    (void)hipMemsetAsync(p.BAR, 0, (8192 + XCD_BAR_WORDS) * 4, stream);
    void* args[] = {&p};
    hipError_t e = hipLaunchCooperativeKernel((const void*)fwd_mega, dim3(grid_blocks), dim3(NTHR), args, LDS_BYTES + 16, stream);
    if (e != hipSuccess) fprintf(stderr, "cooperative launch failed: %s (grid %d)\n", hipGetErrorString(e), grid_blocks);
#else
    static int inited = 0;
    if (!inited) { inited = 1;
        hipFuncSetAttribute((const void*)k_phase<0>, hipFuncAttributeMaxDynamicSharedMemorySize, LDS_BYTES);
        hipFuncSetAttribute((const void*)k_phase<1>, hipFuncAttributeMaxDynamicSharedMemorySize, LDS_BYTES);
        hipFuncSetAttribute((const void*)k_phase<2>, hipFuncAttributeMaxDynamicSharedMemorySize, LDS_BYTES);
        hipFuncSetAttribute((const void*)k_phase<3>, hipFuncAttributeMaxDynamicSharedMemorySize, LDS_BYTES);
        hipFuncSetAttribute((const void*)k_phase<4>, hipFuncAttributeMaxDynamicSharedMemorySize, LDS_BYTES);
        hipFuncSetAttribute((const void*)k_phase<5>, hipFuncAttributeMaxDynamicSharedMemorySize, LDS_BYTES);
        hipFuncSetAttribute((const void*)k_phase<6>, hipFuncAttributeMaxDynamicSharedMemorySize, LDS_BYTES);
        hipFuncSetAttribute((const void*)k_phase<7>, hipFuncAttributeMaxDynamicSharedMemorySize, LDS_BYTES);
    }
    const int G = 256;
#define LP(k) do { k_phase<k><<<G, NTHR, LDS_BYTES, stream>>>(p); if ((REPEAT_MASK >> k) & 1) k_phase<k><<<G, NTHR, LDS_BYTES, stream>>>(p); } while (0)
    LP(0); LP(1); LP(2); LP(3); LP(4); LP(5); LP(6);
#endif
}
```
